# Optimizing an MI355X kernel written in HIP

```python
import jax, jax.numpy as jnp
from jax import lax
import numpy as np


D_MODEL = 1024
BATCH = 32
SEQ = 2048
DEPTH = 2

CHUNK = 64
N_META = 16
EPS = 1e-6
N_EVEN = (DEPTH + 1) // 2
N_ODD = DEPTH // 2
CONV_W = 4

LRU_WIDTH = D_MODEL
LRU_BLOCKS = 4
LRU_BLOCK = LRU_WIDTH // LRU_BLOCKS
RG_LRU_C = 8.0

SSD_WIDTH = D_MODEL
SSD_HEAD_DIM = 64
SSD_HEADS = SSD_WIDTH // SSD_HEAD_DIM
SSD_GROUPS = 2
SSD_HPG = SSD_HEADS // SSD_GROUPS
SSD_STATE = 128
SSD_CHUNK = CHUNK
SSD_CONV_DIM = SSD_WIDTH + 2 * SSD_GROUPS * SSD_STATE

EVEN_SPLITS = (LRU_WIDTH, 2 * LRU_WIDTH, 2 * LRU_WIDTH + SSD_WIDTH,
               2 * LRU_WIDTH + SSD_WIDTH + SSD_CONV_DIM)
EVEN_IN = 2 * LRU_WIDTH + SSD_WIDTH + SSD_CONV_DIM + SSD_HEADS
EVEN_MIX = LRU_WIDTH + SSD_WIDTH

SB_HEADS = 16
SB_HEAD_DIM = D_MODEL // SB_HEADS
SB_WIDTH = SB_HEADS * SB_HEAD_DIM
SB_BLOCK = 128
ODD_IN = 4 * SB_WIDTH

kernel_name = 'hybrid_rglru_ssd_stickbreaking_meta'


def rmsnorm(x, w):
    xf = x.astype(jnp.float32)
    y = xf * lax.rsqrt(jnp.mean(xf * xf, axis=-1, keepdims=True) + EPS)
    return (y * w.astype(jnp.float32)).astype(x.dtype)


def causal_dwconv(u, w, b):
    out = lax.conv_general_dilated(
        u, w[:, None, :].astype(u.dtype), window_strides=(1,),
        padding=[(CONV_W - 1, 0)], dimension_numbers=('NWC', 'WIO', 'NWC'),
        feature_group_count=u.shape[-1])
    return out + b


def linear_scan(a, b):
    def combine(left, right):
        al, bl = left
        ar, br = right
        return al * ar, ar * bl + br
    _, h = lax.associative_scan(combine, (a, b), axis=1)
    return h


def rg_lru(u, w_a, b_a, w_x, b_x, lam):
    bsz, L, _ = u.shape
    uf = u.astype(jnp.float32)
    ub = uf.reshape(bsz, L, LRU_BLOCKS, LRU_BLOCK)
    r = jax.nn.sigmoid(jnp.einsum('blgi,gij->blgj', ub, w_a).reshape(bsz, L, LRU_WIDTH) + b_a)
    i = jax.nn.sigmoid(jnp.einsum('blgi,gij->blgj', ub, w_x).reshape(bsz, L, LRU_WIDTH) + b_x)
    log_a = -RG_LRU_C * r * jax.nn.softplus(-lam)
    a = jnp.exp(log_a)
    mult = jnp.sqrt(-jnp.expm1(2.0 * log_a))
    return linear_scan(a, mult * i * uf)


def ssd_scan(xh, dt, a, bmat, cmat):
    bsz, L, _, _ = xh.shape
    pad = (-L) % SSD_CHUNK
    def padf(t):
        return jnp.pad(t, [(0, 0), (pad, 0)] + [(0, 0)] * (t.ndim - 2))
    f32 = jnp.float32
    xdt = padf((xh * dt[..., None]).astype(f32))
    adt = padf((dt * a).astype(f32))
    bm = padf(bmat.astype(f32))
    cm = padf(cmat.astype(f32))
    nc = (L + pad) // SSD_CHUNK
    X = xdt.reshape(bsz, nc, SSD_CHUNK, SSD_GROUPS, SSD_HPG, SSD_HEAD_DIM)
    A = adt.reshape(bsz, nc, SSD_CHUNK, SSD_GROUPS, SSD_HPG).transpose(0, 3, 4, 1, 2)
    Bc = bm.reshape(bsz, nc, SSD_CHUNK, SSD_GROUPS, SSD_STATE)
    Cc = cm.reshape(bsz, nc, SSD_CHUNK, SSD_GROUPS, SSD_STATE)
    a_cum = jnp.cumsum(A, axis=-1)
    tri = jnp.tril(jnp.ones((SSD_CHUNK, SSD_CHUNK), bool))
    seg = a_cum[..., :, None] - a_cum[..., None, :]
    decay = jnp.exp(jnp.where(tri, seg, -jnp.inf))
    cb = jnp.einsum('bclgn,bcsgn->bcgls', Cc, Bc)
    y_diag = jnp.einsum('bcgls,bgecls,bcsgep->bclgep', cb, decay, X)
    decay_states = jnp.exp(a_cum[..., -1:] - a_cum)
    states = jnp.einsum('bclgn,bgecl,bclgep->bcgepn', Bc, decay_states, X)
    chunk_tot = jnp.pad(a_cum[..., -1], [(0, 0), (0, 0), (0, 0), (1, 0)])
    cs = jnp.cumsum(chunk_tot, axis=-1)
    tri_c = jnp.tril(jnp.ones((nc + 1, nc + 1), bool))
    decay_chunk = jnp.exp(jnp.where(tri_c, cs[..., :, None] - cs[..., None, :], -jnp.inf))
    states = jnp.concatenate([jnp.zeros_like(states[:, :1]), states], axis=1)
    states = jnp.einsum('bgezc,bcgepn->bzgepn', decay_chunk, states)[:, :-1]
    y_off = jnp.einsum('bclgn,bcgepn,bgecl->bclgep', Cc, states, jnp.exp(a_cum))
    y = (y_diag + y_off).reshape(bsz, L + pad, SSD_HEADS, SSD_HEAD_DIM)
    return y[:, pad:]


def gated_group_rmsnorm(y, z, w):
    bsz, L, W = y.shape
    g = (y * jax.nn.silu(z.astype(jnp.float32))).reshape(bsz, L, SSD_GROUPS, W // SSD_GROUPS)
    g = g * lax.rsqrt(jnp.mean(g * g, axis=-1, keepdims=True) + EPS)
    return g.reshape(bsz, L, W) * w.astype(jnp.float32)


def rglru_ssd_layer(h, norm_w, w_in, lru_conv_w, lru_conv_b, lru_w_a, lru_b_a,
                    lru_w_x, lru_b_x, lru_lambda, ssd_conv_w, ssd_conv_b,
                    ssd_dt_bias, ssd_a_log, ssd_d, ssd_norm, w_out):
    bsz, L, _ = h.shape
    u = rmsnorm(h, norm_w)
    proj = u @ w_in
    lru_x, lru_g, ssd_z, ssd_xbc, ssd_dt = jnp.split(proj, EVEN_SPLITS, axis=-1)
    lx = causal_dwconv(lru_x, lru_conv_w, lru_conv_b)
    y_a = rg_lru(lx, lru_w_a, lru_b_a, lru_w_x, lru_b_x, lru_lambda) * jax.nn.silu(lru_g.astype(jnp.float32))
    xbc = jax.nn.silu(causal_dwconv(ssd_xbc, ssd_conv_w, ssd_conv_b))
    xs, bm, cm = jnp.split(xbc, (SSD_WIDTH, SSD_WIDTH + SSD_GROUPS * SSD_STATE), axis=-1)
    dt = jax.nn.softplus(ssd_dt.astype(jnp.float32) + ssd_dt_bias)
    a = -jnp.exp(ssd_a_log.astype(jnp.float32))
    xh = xs.reshape(bsz, L, SSD_HEADS, SSD_HEAD_DIM)
    y = ssd_scan(xh, dt, a,
                 bm.reshape(bsz, L, SSD_GROUPS, SSD_STATE),
                 cm.reshape(bsz, L, SSD_GROUPS, SSD_STATE))
    y = y + xh.astype(jnp.float32) * ssd_d[:, None]
    y_b = gated_group_rmsnorm(y.reshape(bsz, L, SSD_WIDTH), ssd_z, ssd_norm)
    mixed = jnp.concatenate([y_a, y_b], axis=-1).astype(h.dtype)
    return h + mixed @ w_out


def stick_breaking_block(q_blk, k_ctx, v_ctx, q0):
    tq = q_blk.shape[1]
    s_len = k_ctx.shape[1]
    z = jnp.einsum('bthd,bshd->bhts', q_blk.astype(jnp.float32),
                   k_ctx.astype(jnp.float32)) * (SB_HEAD_DIM ** -0.5)
    before = jnp.arange(s_len)[None, :] < (q0 + jnp.arange(tq))[:, None]
    log_keep = jnp.where(before, jax.nn.log_sigmoid(-z), 0.0)
    csum = jnp.cumsum(log_keep, axis=-1)
    weights = jnp.where(before, jnp.exp(jax.nn.log_sigmoid(z) + csum[..., -1:] - csum), 0.0)
    return jnp.einsum('bhts,bshd->bthd', weights, v_ctx.astype(jnp.float32))


def stick_breaking_layer(h, norm_w, w_in, w_out):
    bsz, L, _ = h.shape
    u = rmsnorm(h, norm_w)
    q, k, v, g = jnp.split(u @ w_in, 4, axis=-1)
    q = q.reshape(bsz, L, SB_HEADS, SB_HEAD_DIM)
    k = k.reshape(bsz, L, SB_HEADS, SB_HEAD_DIM)
    v = v.reshape(bsz, L, SB_HEADS, SB_HEAD_DIM)
    bounds = [0] + list(range(N_META, L, SB_BLOCK)) + [L]
    outs = [stick_breaking_block(q[:, s:e], k[:, :e], v[:, :e], s)
            for s, e in zip(bounds[:-1], bounds[1:])]
    o = jnp.concatenate(outs, axis=1).reshape(bsz, L, SB_WIDTH)
    o = (o * jax.nn.silu(g.astype(jnp.float32))).astype(h.dtype)
    return h + o @ w_out


def setup_inputs(seed: int = 0) -> dict:
    key = jax.random.key(seed)
    ks = jax.random.split(key, 24)
    f32 = jnp.float32

    def nrm(k, shape, fan_in):
        return jax.random.normal(k, shape, f32) * (fan_in ** -0.5)

    def gain(k, shape):
        return 1.0 + 0.05 * jax.random.normal(k, shape, f32)

    def bias(k, shape, s=0.05):
        return s * jax.random.normal(k, shape, f32)

    x = jax.random.normal(ks[0], (BATCH, SEQ, D_MODEL), f32)
    meta = jax.random.normal(ks[1], (N_META, D_MODEL), f32)
    even_norm = gain(ks[2], (N_EVEN, D_MODEL))
    even_w_in = nrm(ks[3], (N_EVEN, D_MODEL, EVEN_IN), D_MODEL)
    lru_conv_w = nrm(ks[4], (N_EVEN, CONV_W, LRU_WIDTH), CONV_W)
    lru_conv_b = bias(ks[5], (N_EVEN, LRU_WIDTH))
    lru_w_a = nrm(ks[6], (N_EVEN, LRU_BLOCKS, LRU_BLOCK, LRU_BLOCK), LRU_BLOCK)
    lru_b_a = bias(ks[7], (N_EVEN, LRU_WIDTH), 0.1)
    lru_w_x = nrm(ks[8], (N_EVEN, LRU_BLOCKS, LRU_BLOCK, LRU_BLOCK), LRU_BLOCK)
    lru_b_x = bias(ks[9], (N_EVEN, LRU_WIDTH), 0.1)
    a_c = jax.random.uniform(ks[10], (N_EVEN, LRU_WIDTH), f32, minval=0.9, maxval=0.999)
    a0 = a_c ** (1.0 / RG_LRU_C)
    lru_lambda = jnp.log(a0) - jnp.log1p(-a0)
    ssd_conv_w = nrm(ks[11], (N_EVEN, CONV_W, SSD_CONV_DIM), CONV_W)
    ssd_conv_b = bias(ks[12], (N_EVEN, SSD_CONV_DIM))
    dt0 = jnp.exp(jax.random.uniform(ks[13], (N_EVEN, SSD_HEADS), f32,
                                     minval=float(np.log(1e-3)), maxval=float(np.log(1e-1))))
    ssd_dt_bias = dt0 + jnp.log(-jnp.expm1(-dt0))
    ssd_a_log = jnp.log(jax.random.uniform(ks[14], (N_EVEN, SSD_HEADS), f32, minval=1.0, maxval=16.0))
    ssd_d = gain(ks[15], (N_EVEN, SSD_HEADS))
    ssd_norm = gain(ks[16], (N_EVEN, SSD_WIDTH))
    even_w_out = nrm(ks[17], (N_EVEN, EVEN_MIX, D_MODEL), EVEN_MIX)
    odd_norm = gain(ks[18], (N_ODD, D_MODEL))
    odd_w_in = nrm(ks[19], (N_ODD, D_MODEL, ODD_IN), D_MODEL)
    odd_w_out = nrm(ks[20], (N_ODD, SB_WIDTH, D_MODEL), SB_WIDTH)
    final_norm = gain(ks[21], (D_MODEL,))
    return {'x': x, 'meta': meta, 'even_norm': even_norm, 'even_w_in': even_w_in,
            'lru_conv_w': lru_conv_w, 'lru_conv_b': lru_conv_b,
            'lru_w_a': lru_w_a, 'lru_b_a': lru_b_a, 'lru_w_x': lru_w_x, 'lru_b_x': lru_b_x,
            'lru_lambda': lru_lambda, 'ssd_conv_w': ssd_conv_w, 'ssd_conv_b': ssd_conv_b,
            'ssd_dt_bias': ssd_dt_bias, 'ssd_a_log': ssd_a_log, 'ssd_d': ssd_d,
            'ssd_norm': ssd_norm, 'even_w_out': even_w_out, 'odd_norm': odd_norm,
            'odd_w_in': odd_w_in, 'odd_w_out': odd_w_out, 'final_norm': final_norm}


def reference(x, meta, even_norm, even_w_in, lru_conv_w, lru_conv_b, lru_w_a, lru_b_a,
              lru_w_x, lru_b_x, lru_lambda, ssd_conv_w, ssd_conv_b, ssd_dt_bias,
              ssd_a_log, ssd_d, ssd_norm, even_w_out, odd_norm, odd_w_in, odd_w_out,
              final_norm):
    bsz = x.shape[0]
    meta_b = jnp.broadcast_to(meta[None].astype(x.dtype), (bsz, N_META, D_MODEL))
    h = jnp.concatenate([meta_b, x], axis=1)
    for layer in range(DEPTH):
        j = layer // 2
        if layer % 2 == 0:
            h = rglru_ssd_layer(h, even_norm[j], even_w_in[j], lru_conv_w[j], lru_conv_b[j],
                                lru_w_a[j], lru_b_a[j], lru_w_x[j], lru_b_x[j], lru_lambda[j],
                                ssd_conv_w[j], ssd_conv_b[j], ssd_dt_bias[j], ssd_a_log[j],
                                ssd_d[j], ssd_norm[j], even_w_out[j])
        else:
            h = stick_breaking_layer(h, odd_norm[j], odd_w_in[j], odd_w_out[j])
    return rmsnorm(h, final_norm)[:, N_META:].astype(x.dtype)
```

```cpp
#include <hip/hip_runtime.h>
#include <hip/hip_cooperative_groups.h>
#include <cstdint>
#include <cstdio>
namespace cg = cooperative_groups;

#ifndef N_LAUNCH_MODE
#define N_LAUNCH_MODE 1
#endif
#ifndef SSD_NAIVE
#define SSD_NAIVE 1
#endif
#ifndef ATTN_NAIVE
#define ATTN_NAIVE 1
#endif

#define LAS __attribute__((address_space(3)))
typedef unsigned short bf16_t;
typedef short bf16x8 __attribute__((ext_vector_type(8)));
typedef float f32x4 __attribute__((ext_vector_type(4)));
typedef float f32x2 __attribute__((ext_vector_type(2)));
typedef unsigned u32x4 __attribute__((ext_vector_type(4)));
typedef unsigned u32x2 __attribute__((ext_vector_type(2)));
typedef __bf16 bf16x2_t __attribute__((ext_vector_type(2)));

constexpr int NB = 32, SEQ = 2048, NMETA = 16, LL = SEQ + NMETA, DM = 1024;
constexpr int MREAL = NB * SEQ;
constexpr int MTOT = MREAL + NB * NMETA;
constexpr int EVEN_IN = 4624, N0PAD = 4864, LD0 = 4624;
constexpr int C_LRUX = 0, C_LRUG = 1024, C_Z = 2048, C_XBC = 3072, C_DT = 4608;
constexpr int XBCW = 1536;
constexpr int LD1 = 4096;
constexpr float EPS = 1e-6f;
constexpr int NTHREADS = 512;

constexpr size_t MiB = 1u << 20;
constexpr size_t OFF_W0T = 0;
constexpr size_t OFF_WGT = 10 * MiB;
constexpr size_t OFF_WO0T = 11 * MiB;
constexpr size_t OFF_W1T = 15 * MiB;
constexpr size_t OFF_WO1T = 23 * MiB;
constexpr size_t OFF_STATS = 25 * MiB;
constexpr size_t OFF_XB = 27 * MiB;
constexpr size_t SZ_ACT = (size_t)MTOT * 1024 * 2;
constexpr size_t OFF_P0 = OFF_XB + SZ_ACT;
constexpr size_t SZ_P0 = (size_t)MTOT * LD0 * 2;
constexpr size_t OFF_LA = OFF_P0 + SZ_P0;
constexpr size_t OFF_BB = OFF_LA + SZ_ACT;
constexpr size_t WS_END = OFF_BB + SZ_ACT;
static_assert(WS_END <= (size_t)1024 * MiB, "workspace map");

struct Params {
    const float* x; const float* meta; const float* even_norm; const float* even_w_in;
    const float* lru_conv_w; const float* lru_conv_b; const float* lru_w_a; const float* lru_b_a;
    const float* lru_w_x; const float* lru_b_x; const float* lru_lambda; const float* ssd_conv_w;
    const float* ssd_conv_b; const float* ssd_dt_bias; const float* ssd_a_log; const float* ssd_d;
    const float* ssd_norm; const float* even_w_out; const float* odd_norm; const float* odd_w_in;
    const float* odd_w_out; const float* final_norm;
    float* out; unsigned char* ws;
    int ph_lo, ph_hi;
};

__device__ __forceinline__ unsigned pk2(float lo, float hi) { f32x2 v = {lo, hi}; bf16x2_t b = __builtin_convertvector(v, bf16x2_t); return __builtin_bit_cast(unsigned, b); }
__device__ __forceinline__ float bflo(unsigned w) { return __uint_as_float(w << 16); }
__device__ __forceinline__ float bfhi(unsigned w) { return __uint_as_float(w & 0xffff0000u); }
__device__ __forceinline__ float bf2f(bf16_t h) { return __uint_as_float((unsigned)h << 16); }
__device__ __forceinline__ bf16_t f2bf(float f) { return (bf16_t)(pk2(f, 0.f) & 0xffffu); }
__device__ __forceinline__ int rowof(int b, int t) { return t >= NMETA ? b * SEQ + (t - NMETA) : MREAL + b * NMETA + t; }
__device__ __forceinline__ float sigmoidf_(float v) { return 1.f / (1.f + __expf(-v)); }
__device__ __forceinline__ float siluf_(float v) { return v / (1.f + __expf(-v)); }
__device__ __forceinline__ float softplusf_(float v) { return fmaxf(v, 0.f) + log1pf(__expf(-fabsf(v))); }
__device__ __forceinline__ float wave_sum(float v) {
#pragma unroll
    for (int o = 1; o < 64; o <<= 1) v += __shfl_xor(v, o);
    return v;
}

namespace pg8 {
constexpr int BM = 256, BK = 64, HALF = 128, HTB = HALF * BK * 2, STAGE_BYTES = 8 * HTB, NXCD = 8, WGM = 8;
__host__ __device__ __forceinline__ int lds_byte(int r, int c) { const int st = (r >> 4) * 2 + (c >> 5), rr = r & 15, cc = c & 31, ob = rr * 64 + cc * 2; return st * 1024 + (ob ^ (((ob >> 9) & 1) << 5)); }
__host__ __device__ __forceinline__ void stage_rc(int b, int& R, int& C) { const int st = b / 1024, sb = b % 1024, swz = sb ^ (((sb >> 9) & 1) << 5); R = (st >> 1) * 16 + swz / 64; C = (st & 1) * 32 + (swz % 64) / 2; }
__host__ __device__ __forceinline__ int perm32(int rho) { const int n = rho >> 4, i = rho & 15; return 8 * (i >> 2) + 4 * n + (i & 3); }

struct Unit { int pm, pn; };
struct Gemm { const bf16_t* A; const bf16_t* Bt; int lda, ldb, K, agrp; };
struct StaticOrder {
    int nM, nN, nwg, G, c;
    __device__ void init(int nM_, int nN_, int G_, int c_) { nM = nM_; nN = nN_; nwg = nM * nN; G = G_; c = c_; }
    __device__ bool next(int i, Unit& u) const {
        const long L = (long)i * G + c; if (L >= nwg) return false;
        int wgid = (int)L; { const int q = nwg / NXCD, r = nwg % NXCD, xcd = wgid % NXCD, off = wgid / NXCD; wgid = (xcd < r ? xcd * (q + 1) : r * (q + 1) + (xcd - r) * q) + off; }
        const int nig = WGM * nN, gid = wgid / nig, fm = gid * WGM, gsz = (nM - fm) < WGM ? (nM - fm) : WGM;
        u.pm = fm + ((wgid % nig) % gsz); u.pn = (wgid % nig) / gsz; return true;
    }
};

struct EpiScaleBf16 {
    static constexpr bool PERM = true;
    bf16_t* O; int ldc; const float* rsq; int ncols;
    __device__ __forceinline__ void operator()(const f32x4 (&acc)[2][2][4][2], const Unit& u, int wr, int wc, int fr, int fq) const {
        const int row0 = u.pm * BM + wr * 64 + fr, col0 = u.pn * BM + wc * 32 + 8 * fq;
#pragma unroll
        for (int ai = 0; ai < 2; ++ai)
#pragma unroll
            for (int m = 0; m < 4; ++m) {
                const int row = row0 + ai * HALF + m * 16;
                const float s = rsqrtf(rsq[row] * (1.f / 1024.f) + EPS);
                bf16_t* rowp = O + (size_t)row * ldc + col0;
#pragma unroll
                for (int bj = 0; bj < 2; ++bj) {
                    if (col0 + bj * HALF < ncols) {
                        const f32x4 v0 = acc[ai][bj][m][0] * s, v1 = acc[ai][bj][m][1] * s;
                        u32x4 w; w.x = pk2(v0[0], v0[1]); w.y = pk2(v0[2], v0[3]); w.z = pk2(v1[0], v1[1]); w.w = pk2(v1[2], v1[3]);
                        *(u32x4*)(rowp + bj * HALF) = w;
                    }
                }
            }
    }
};
struct EpiGates {
    static constexpr bool PERM = false;
    const bf16_t* lx; const float* b_a; const float* b_x; const float* lam; bf16_t* la; bf16_t* bb;
    __device__ __forceinline__ void operator()(const f32x4 (&acc)[2][2][4][2], const Unit& u, int wr, int wc, int fr, int fq) const {
        const int row0 = u.pm * BM + wr * 64 + fr;
        const int ch0 = (u.pn >> 1) * 256 + (u.pn & 1) * 128 + wc * 32 + 4 * fq;
#pragma unroll
        for (int ai = 0; ai < 2; ++ai)
#pragma unroll
            for (int m = 0; m < 4; ++m) {
                const int row = row0 + ai * HALF + m * 16;
#pragma unroll
                for (int n = 0; n < 2; ++n) {
                    const int ch = ch0 + 16 * n;
                    const f32x4 ba = *(const f32x4*)(b_a + ch), bx = *(const f32x4*)(b_x + ch), cneg = *(const f32x4*)(lam + ch);
                    const u32x2 lw = *(const u32x2*)(lx + (size_t)row * 1024 + ch);
                    const float lxv[4] = {bflo(lw.x), bfhi(lw.x), bflo(lw.y), bfhi(lw.y)};
                    float lo[4], bo[4];
#pragma unroll
                    for (int j = 0; j < 4; ++j) {
                        const float r = sigmoidf_(acc[ai][0][m][n][j] + ba[j]);
                        const float ig = sigmoidf_(acc[ai][1][m][n][j] + bx[j]);
                        const float loga = cneg[j] * r;
                        const float a2 = __expf(2.f * loga);
                        lo[j] = loga; bo[j] = sqrtf(fmaxf(1.f - a2, 0.f)) * ig * lxv[j];
                    }
                    u32x2 w0; w0.x = pk2(lo[0], lo[1]); w0.y = pk2(lo[2], lo[3]);
                    u32x2 w1; w1.x = pk2(bo[0], bo[1]); w1.y = pk2(bo[2], bo[3]);
                    *(u32x2*)(la + (size_t)row * 1024 + ch) = w0;
                    *(u32x2*)(bb + (size_t)row * 1024 + ch) = w1;
                    asm volatile("" ::: "memory");
                }
            }
    }
};
struct EpiOut0 {
    static constexpr bool PERM = false;
    const float* x; const float* meta; bf16_t* h1b; float* rsq;
    __device__ __forceinline__ void operator()(const f32x4 (&acc)[2][2][4][2], const Unit& u, int wr, int wc, int fr, int fq) const {
        const int row0 = u.pm * BM + wr * 64 + fr, col0 = u.pn * BM + wc * 32 + 4 * fq;
#pragma unroll
        for (int ai = 0; ai < 2; ++ai)
#pragma unroll
            for (int m = 0; m < 4; ++m) {
                const int row = row0 + ai * HALF + m * 16;
                const float* src = row < MREAL ? x + (size_t)row * 1024 : meta + (size_t)((row - MREAL) & 15) * 1024;
                float ss = 0.f;
#pragma unroll
                for (int bj = 0; bj < 2; ++bj)
#pragma unroll
                    for (int n = 0; n < 2; ++n) {
                        const int col = col0 + bj * HALF + n * 16;
                        const f32x4 v = acc[ai][bj][m][n] + *(const f32x4*)(src + col);
                        ss += (v[0] * v[0] + v[1] * v[1]) + (v[2] * v[2] + v[3] * v[3]);
                        u32x2 w; w.x = pk2(v[0], v[1]); w.y = pk2(v[2], v[3]);
                        *(u32x2*)(h1b + (size_t)row * 1024 + col) = w;
                    }
                ss += __shfl_xor(ss, 16); ss += __shfl_xor(ss, 32);
                if (fq == 0) atomicAdd(rsq + row, ss);
            }
    }
};
struct EpiOut1 {
    static constexpr bool PERM = false;
    const bf16_t* h1b; float* out; float* rsq;
    __device__ __forceinline__ void operator()(const f32x4 (&acc)[2][2][4][2], const Unit& u, int wr, int wc, int fr, int fq) const {
        const int row0 = u.pm * BM + wr * 64 + fr, col0 = u.pn * BM + wc * 32 + 4 * fq;
#pragma unroll
        for (int ai = 0; ai < 2; ++ai)
#pragma unroll
            for (int m = 0; m < 4; ++m) {
                const int row = row0 + ai * HALF + m * 16;
                float ss = 0.f;
#pragma unroll
                for (int bj = 0; bj < 2; ++bj)
#pragma unroll
                    for (int n = 0; n < 2; ++n) {
                        const int col = col0 + bj * HALF + n * 16;
                        const u32x2 hw = *(const u32x2*)(h1b + (size_t)row * 1024 + col);
                        f32x4 v = acc[ai][bj][m][n];
                        v[0] += bflo(hw.x); v[1] += bfhi(hw.x); v[2] += bflo(hw.y); v[3] += bfhi(hw.y);
                        ss += (v[0] * v[0] + v[1] * v[1]) + (v[2] * v[2] + v[3] * v[3]);
                        *(f32x4*)(out + (size_t)row * 1024 + col) = v;
                    }
                ss += __shfl_xor(ss, 16); ss += __shfl_xor(ss, 32);
                if (fq == 0) atomicAdd(rsq + row, ss);
            }
    }
};

template <class Epi, class Sched>
__device__ __forceinline__ void gemm_phase(LAS unsigned char* lds, const Gemm g, const Sched& S, const Epi& E) {
    const int tid = threadIdx.x, wid = __builtin_amdgcn_readfirstlane(tid >> 6), lane = tid & 63, wr = wid >> 2, wc = wid & 3, fr = lane & 15, fq = lane >> 4;
    const int K = g.K, nt = K / BK;
    unsigned voffA[2], voffB[2];
#pragma unroll
    for (int i = 0; i < 2; ++i) { int R, C; stage_rc(tid * 16 + i * 8192, R, C); const int Rb = Epi::PERM ? ((R & ~31) + perm32(R & 31)) : R;
        voffA[i] = (unsigned)(R * g.lda + C) * 2u; voffB[i] = (unsigned)(Rb * g.ldb + C) * 2u; }
    const size_t kstep = (size_t)(BK * 2);
    const size_t hstepA = (size_t)HALF * g.lda * 2, hstepB = (size_t)HALF * g.ldb * 2;
    const size_t tstepA = 2 * hstepA, tstepB = 2 * hstepB;
    const unsigned ldsw = (unsigned)wid * 1024u;
    const int aoff = lds_byte(wr * 64 + fr, fq * 8), boff = lds_byte(wc * 32 + fr, fq * 8);
#define PG8_SA(b, h) (((b) * 2 + (h)) * HTB)
#define PG8_SB(b, h) ((4 + (b) * 2 + (h)) * HTB)
#define PG8_STAGE(bufoff, gbase, voff) do { _Pragma("unroll") for (int _i = 0; _i < 2; ++_i) \
        __builtin_amdgcn_global_load_lds((const unsigned*)((const char*)(gbase) + (voff)[_i]), (LAS unsigned*)(lds + (bufoff) + ldsw + _i * 8192), 16, 0, 0); } while (0)
#define PG8_LDA(dst, b, h) do { _Pragma("unroll") for (int m = 0; m < 4; ++m) _Pragma("unroll") for (int k = 0; k < 2; ++k) dst[m][k] = *(const LAS bf16x8*)(lds + PG8_SA(b, h) + aoff + m * 2048 + k * 1024); } while (0)
#define PG8_LDB(dst, b, h) do { _Pragma("unroll") for (int n = 0; n < 2; ++n) _Pragma("unroll") for (int k = 0; k < 2; ++k) dst[n][k] = *(const LAS bf16x8*)(lds + PG8_SB(b, h) + boff + n * 2048 + k * 1024); } while (0)
#define PG8_MMA(ai, bj, At, Bt) do { __builtin_amdgcn_s_setprio(1); _Pragma("unroll") for (int m = 0; m < 4; ++m) _Pragma("unroll") for (int n = 0; n < 2; ++n) _Pragma("unroll") for (int k = 0; k < 2; ++k) \
        acc[ai][bj][m][n] = __builtin_amdgcn_mfma_f32_16x16x32_bf16(Bt[n][k], At[m][k], acc[ai][bj][m][n], 0, 0, 0); __builtin_amdgcn_s_setprio(0); } while (0)
#define PG8_WAIT_V(n) asm volatile("s_waitcnt vmcnt(" #n ")" ::: "memory")
#define PG8_WAIT_L(n) asm volatile("s_waitcnt lgkmcnt(" #n ")" ::: "memory")
#define PG8_BAR __builtin_amdgcn_s_barrier()
#define PG8_SCHED __builtin_amdgcn_sched_barrier(0)
    Unit cur, nxt; int ui = 0;
    if (!S.next(0, cur)) return;
    f32x4 acc[2][2][4][2];
#pragma unroll
    for (int a = 0; a < 2; ++a)
#pragma unroll
        for (int b = 0; b < 2; ++b)
#pragma unroll
            for (int m = 0; m < 4; ++m)
#pragma unroll
                for (int n = 0; n < 2; ++n) acc[a][b][m][n] = (f32x4){0.f, 0.f, 0.f, 0.f};
    bf16x8 At[4][2], B0[2][2], B1[2][2];
    const char* cA = (const char*)g.A + (size_t)cur.pm * tstepA + (size_t)((cur.pn >> 1) * g.agrp) * 2; const char* cB = (const char*)g.Bt + (size_t)cur.pn * tstepB;
    PG8_STAGE(PG8_SB(0, 0), cB, voffB); PG8_STAGE(PG8_SB(0, 1), cB + hstepB, voffB); PG8_STAGE(PG8_SA(0, 0), cA, voffA); PG8_STAGE(PG8_SA(0, 1), cA + hstepA, voffA);
    if (wr == 1) PG8_BAR;
    PG8_WAIT_V(2); PG8_BAR;
    PG8_STAGE(PG8_SB(1, 0), cB + kstep, voffB); PG8_STAGE(PG8_SA(1, 0), cA + kstep, voffA); PG8_STAGE(PG8_SB(1, 1), cB + hstepB + kstep, voffB);
    PG8_WAIT_V(6); PG8_BAR;
    for (;;) {
        const bool has_next = S.next(ui + 1, nxt);
        const char* nA = has_next ? (const char*)g.A + (size_t)nxt.pm * tstepA + (size_t)((nxt.pn >> 1) * g.agrp) * 2 : cA; const char* nB = has_next ? (const char*)g.Bt + (size_t)nxt.pn * tstepB : cB;
        for (int t = 0; t < nt; t += 2) {
            const bool last = (t == nt - 2);
            const char* a1 = cA + (size_t)(t + 1) * kstep;
            const char* a2 = last ? nA : cA + (size_t)(t + 2) * kstep; const char* b2 = last ? nB : cB + (size_t)(t + 2) * kstep;
            const char* a3 = a2 + kstep; const char* b3 = b2 + kstep;
            PG8_LDB(B0, 0, 0); PG8_LDB(B1, 0, 1); PG8_SCHED; PG8_LDA(At, 0, 0); PG8_STAGE(PG8_SA(1, 1), a1 + hstepA, voffA);
            PG8_WAIT_V(8); PG8_WAIT_L(0); PG8_BAR; PG8_MMA(0, 0, At, B0); PG8_MMA(0, 1, At, B1); PG8_BAR; PG8_SCHED;
            PG8_LDA(At, 0, 1); PG8_STAGE(PG8_SB(0, 0), b2, voffB); PG8_STAGE(PG8_SB(0, 1), b2 + hstepB, voffB); PG8_STAGE(PG8_SA(0, 0), a2, voffA);
            PG8_WAIT_V(8); PG8_WAIT_L(0); PG8_BAR; PG8_MMA(1, 0, At, B0); PG8_MMA(1, 1, At, B1); PG8_BAR; PG8_SCHED;
            PG8_LDB(B0, 1, 0); PG8_LDB(B1, 1, 1); PG8_SCHED; PG8_LDA(At, 1, 0); PG8_STAGE(PG8_SA(0, 1), a2 + hstepA, voffA);
            PG8_WAIT_V(8); PG8_WAIT_L(0); PG8_BAR; PG8_MMA(0, 0, At, B0); PG8_MMA(0, 1, At, B1); PG8_BAR; PG8_SCHED;
            PG8_LDA(At, 1, 1); PG8_STAGE(PG8_SB(1, 0), b3, voffB); PG8_STAGE(PG8_SB(1, 1), b3 + hstepB, voffB); PG8_STAGE(PG8_SA(1, 0), a3, voffA);
            PG8_WAIT_V(8); PG8_WAIT_L(0); PG8_BAR; PG8_MMA(1, 0, At, B0); PG8_MMA(1, 1, At, B1); PG8_BAR; PG8_SCHED;
        }
        if (wr == 0) PG8_BAR;
        E(acc, cur, wr, wc, fr, fq);
        if (!has_next) break;
#pragma unroll
        for (int a = 0; a < 2; ++a)
#pragma unroll
            for (int b = 0; b < 2; ++b)
#pragma unroll
                for (int m = 0; m < 4; ++m)
#pragma unroll
                    for (int n = 0; n < 2; ++n) acc[a][b][m][n] = (f32x4){0.f, 0.f, 0.f, 0.f};
        cur = nxt; cA = nA; cB = nB; ++ui;
        if (wr == 1) PG8_BAR;
    }
    PG8_WAIT_V(0);
    PG8_BAR;
#undef PG8_SA
#undef PG8_SB
#undef PG8_STAGE
#undef PG8_LDA
#undef PG8_LDB
#undef PG8_MMA
#undef PG8_WAIT_V
#undef PG8_WAIT_L
#undef PG8_BAR
#undef PG8_SCHED
}
}

__device__ __forceinline__ void transpose_tile(const float* src, int src_ld, int n_valid, int k0, int n0, bf16_t* dst, int dst_ld, int dst_row0, const float* kscale, float* scr, int lane) {
#pragma unroll 8
    for (int i = 0; i < 32; ++i) {
        const int kk = 2 * i + (lane >> 5), n = n0 + (lane & 31);
        float v = n < n_valid ? src[(size_t)(k0 + kk) * src_ld + n] : 0.f;
        if (kscale) v *= kscale[k0 + kk];
        scr[kk * 33 + (lane & 31)] = v;
    }
    asm volatile("s_waitcnt lgkmcnt(0)" ::: "memory");
    const int c = lane & 7;
#pragma unroll
    for (int j = 0; j < 4; ++j) {
        const int n = (lane >> 3) + 8 * j; const float* s = scr + (8 * c) * 33 + n;
        u32x4 o; o.x = pk2(s[0 * 33], s[1 * 33]); o.y = pk2(s[2 * 33], s[3 * 33]); o.z = pk2(s[4 * 33], s[5 * 33]); o.w = pk2(s[6 * 33], s[7 * 33]);
        *(u32x4*)(dst + (size_t)(dst_row0 + n) * dst_ld + k0 + 8 * c) = o;
    }
    asm volatile("s_waitcnt lgkmcnt(0)" ::: "memory");
}

__device__ __forceinline__ void phase0(const Params& p, unsigned char* lds) {
    unsigned char* ws = p.ws;
    const int tid = threadIdx.x, lane = tid & 63, wave = tid >> 6;
    const int gw = blockIdx.x * 8 + wave, NGW = gridDim.x * 8;
    float* scr = (float*)(lds + wave * 16384);
    bf16_t* W0T = (bf16_t*)(ws + OFF_W0T); bf16_t* WGT = (bf16_t*)(ws + OFF_WGT); bf16_t* WO0T = (bf16_t*)(ws + OFF_WO0T);
    bf16_t* W1T = (bf16_t*)(ws + OFF_W1T); bf16_t* WO1T = (bf16_t*)(ws + OFF_WO1T);
    constexpr int I_W0 = 16 * 152, I_G = 256, I_O0 = 32 * 32, I_W1 = 16 * 128, I_O1 = 16 * 32;
    constexpr int NIT = I_W0 + I_G + I_O0 + I_W1 + I_O1;
    for (int it = gw; it < NIT; it += NGW) {
        int r = it;
        if (r < I_W0) { const int kb = r / 152, nb = r % 152; transpose_tile(p.even_w_in, EVEN_IN, EVEN_IN, 64 * kb, 32 * nb, W0T, 1024, 32 * nb, p.even_norm, scr, lane); continue; }
        r -= I_W0;
        if (r < I_G) {
            const int nb = r & 3, kb = (r >> 2) & 3, tp = (r >> 4) & 1, which = (r >> 5) & 1, g = r >> 6;
            const float* src = (which ? p.lru_w_x : p.lru_w_a) + (size_t)g * 65536;
            transpose_tile(src, 256, 256, 64 * kb, 128 * tp + 32 * nb, WGT, 256, (2 * g + tp) * 256 + which * 128 + 32 * nb, nullptr, scr, lane); continue; }
        r -= I_G;
        if (r < I_O0) { const int kb = r / 32, nb = r % 32;
            transpose_tile(p.even_w_out, 1024, 1024, 64 * kb, 32 * nb, WO0T, 2048, 32 * nb, kb >= 16 ? p.ssd_norm - 1024 : nullptr, scr, lane); continue; }
        r -= I_O0;
        if (r < I_W1) { const int kb = r / 128, nb = r % 128; transpose_tile(p.odd_w_in, 4096, 4096, 64 * kb, 32 * nb, W1T, 1024, 32 * nb, p.odd_norm, scr, lane); continue; }
        r -= I_W1;
        { const int kb = r / 32, nb = r % 32; transpose_tile(p.odd_w_out, 1024, 1024, 64 * kb, 32 * nb, WO1T, 1024, 32 * nb, nullptr, scr, lane); }
    }
    bf16_t* xb = (bf16_t*)(ws + OFF_XB); float* stats = (float*)(ws + OFF_STATS);
    for (int m = gw; m < MTOT; m += NGW) {
        const float* src = m < MREAL ? p.x + (size_t)m * 1024 : p.meta + (size_t)((m - MREAL) & 15) * 1024;
        const f32x4* xr = (const f32x4*)src + lane; float s = 0.f;
        unsigned long long* o8 = (unsigned long long*)(xb + (size_t)m * 1024) + lane;
#pragma unroll
        for (int j = 0; j < 4; ++j) { const f32x4 v = xr[64 * j]; s += (v[0] * v[0] + v[1] * v[1]) + (v[2] * v[2] + v[3] * v[3]);
            o8[64 * j] = (unsigned long long)pk2(v[0], v[1]) | ((unsigned long long)pk2(v[2], v[3]) << 32); }
        s = wave_sum(s);
        if (lane == 0) stats[m] = s;
    }
    if (blockIdx.x == 0) for (int i = tid; i < 1024; i += NTHREADS) stats[5 * MTOT + i] = -8.f * log1pf(__expf(-p.lru_lambda[i]));
    for (int i = blockIdx.x * NTHREADS + tid; i < 4 * MTOT; i += gridDim.x * NTHREADS) stats[MTOT + i] = 0.f;
}

__device__ __forceinline__ void phase_conv(const Params& p) {
    unsigned char* ws = p.ws;
    const bf16_t* proj = (const bf16_t*)(ws + OFF_P0);
    bf16_t* lx = (bf16_t*)(ws + OFF_XB); bf16_t* xc = (bf16_t*)p.out;
    constexpr int NCH = 320, NTB = LL / 16;
    const long total = (long)NB * NTB * NCH;
    for (long it = (long)blockIdx.x * NTHREADS + threadIdx.x; it < total; it += (long)gridDim.x * NTHREADS) {
        const int c = (int)(it % NCH); const int tb = (int)((it / NCH) % NTB); const int b = (int)(it / ((long)NCH * NTB));
        const bool is_lru = c < 128;
        const int scol = is_lru ? 8 * c : C_XBC + 8 * (c - 128);
        const int wcol = is_lru ? 8 * c : 8 * (c - 128);
        const float* cw = is_lru ? p.lru_conv_w : p.ssd_conv_w; const int cwld = is_lru ? 1024 : XBCW;
        const float* cb = is_lru ? p.lru_conv_b : p.ssd_conv_b;
        float w[4][8], bias[8];
#pragma unroll
        for (int j = 0; j < 4; ++j) { const f32x4 a = *(const f32x4*)(cw + j * cwld + wcol), bq = *(const f32x4*)(cw + j * cwld + wcol + 4);
            w[j][0] = a[0]; w[j][1] = a[1]; w[j][2] = a[2]; w[j][3] = a[3]; w[j][4] = bq[0]; w[j][5] = bq[1]; w[j][6] = bq[2]; w[j][7] = bq[3]; }
        { const f32x4 a = *(const f32x4*)(cb + wcol), bq = *(const f32x4*)(cb + wcol + 4);
            bias[0] = a[0]; bias[1] = a[1]; bias[2] = a[2]; bias[3] = a[3]; bias[4] = bq[0]; bias[5] = bq[1]; bias[6] = bq[2]; bias[7] = bq[3]; }
        float h0[8], h1[8], h2[8];
        const int t0 = tb * 16;
#define LOADROW(dst, tt) do { if ((tt) >= 0) { const u32x4 q = *(const u32x4*)(proj + (size_t)rowof(b, (tt)) * LD0 + scol); \
            dst[0] = bflo(q.x); dst[1] = bfhi(q.x); dst[2] = bflo(q.y); dst[3] = bfhi(q.y); dst[4] = bflo(q.z); dst[5] = bfhi(q.z); dst[6] = bflo(q.w); dst[7] = bfhi(q.w); } \
            else { _Pragma("unroll") for (int e = 0; e < 8; ++e) dst[e] = 0.f; } } while (0)
        LOADROW(h0, t0 - 3); LOADROW(h1, t0 - 2); LOADROW(h2, t0 - 1);
#pragma unroll 4
        for (int i = 0; i < 16; ++i) {
            const int t = t0 + i; float cur[8]; LOADROW(cur, t);
            float o[8];
#pragma unroll
            for (int e = 0; e < 8; ++e) { float v = bias[e] + w[0][e] * h0[e] + w[1][e] * h1[e] + w[2][e] * h2[e] + w[3][e] * cur[e]; o[e] = is_lru ? v : siluf_(v); h0[e] = h1[e]; h1[e] = h2[e]; h2[e] = cur[e]; }
            u32x4 q; q.x = pk2(o[0], o[1]); q.y = pk2(o[2], o[3]); q.z = pk2(o[4], o[5]); q.w = pk2(o[6], o[7]);
            const size_t row = (size_t)rowof(b, t);
            if (is_lru) *(u32x4*)(lx + row * 1024 + wcol) = q; else *(u32x4*)(xc + row * XBCW + wcol) = q;
        }
#undef LOADROW
    }
}

__device__ __forceinline__ void phase_ssd_naive(const Params& p) {
    unsigned char* ws = p.ws;
    bf16_t* proj = (bf16_t*)(ws + OFF_P0); const bf16_t* xc = (const bf16_t*)p.out; float* gsq = (float*)(ws + OFF_STATS) + MTOT;
    const int lane = threadIdx.x & 63, wave = threadIdx.x >> 6;
    for (int item = blockIdx.x * 8 + wave; item < NB * 16 * 2; item += gridDim.x * 8) {
        const int b = item >> 5, h = (item >> 1) & 15, ph = item & 1, g = h >> 3;
        const int pp = ph * 32 + (lane & 31), nh = lane >> 5;
        const float dtb = p.ssd_dt_bias[h], a = -__expf(p.ssd_a_log[h]), dsk = p.ssd_d[h];
        float st[64];
#pragma unroll
        for (int n = 0; n < 64; ++n) st[n] = 0.f;
        for (int t = 0; t < LL; ++t) {
            const size_t row = (size_t)rowof(b, t);
            const float xv = bf2f(xc[row * XBCW + h * 64 + pp]);
            const float dt = softplusf_(bf2f(proj[row * LD0 + C_DT + h]) + dtb);
            const float dA = __expf(dt * a), dx = dt * xv;
            const u32x4* Bp = (const u32x4*)(xc + row * XBCW + 1024 + g * 128 + nh * 64); const u32x4* Cp = (const u32x4*)(xc + row * XBCW + 1280 + g * 128 + nh * 64);
            float y = 0.f;
#pragma unroll
            for (int q = 0; q < 8; ++q) {
                const u32x4 bw = Bp[q], cw = Cp[q];
                const float bv[8] = {bflo(bw.x), bfhi(bw.x), bflo(bw.y), bfhi(bw.y), bflo(bw.z), bfhi(bw.z), bflo(bw.w), bfhi(bw.w)};
                const float cv[8] = {bflo(cw.x), bfhi(cw.x), bflo(cw.y), bfhi(cw.y), bflo(cw.z), bfhi(cw.z), bflo(cw.w), bfhi(cw.w)};
#pragma unroll
                for (int e = 0; e < 8; ++e) { st[q * 8 + e] = dA * st[q * 8 + e] + dx * bv[e]; y += cv[e] * st[q * 8 + e]; }
            }
            y += __shfl_xor(y, 32);
            y += dsk * xv;
            const float z = bf2f(proj[row * LD0 + C_Z + h * 64 + pp]);
            const float gv = y * siluf_(z);
            if (nh == 0) proj[row * LD0 + C_Z + h * 64 + pp] = f2bf(gv);
            const float ss = wave_sum(nh == 0 ? gv * gv : 0.f);
            if (lane == 0) atomicAdd(gsq + row * 2 + g, ss);
        }
    }
}

__device__ __forceinline__ void phase_scan(const Params& p, unsigned char* lds) {
    unsigned char* ws = p.ws;
    bf16_t* proj = (bf16_t*)(ws + OFF_P0); const bf16_t* la = (const bf16_t*)(ws + OFF_LA); const bf16_t* bb = (const bf16_t*)(ws + OFF_BB);
    const int lane = threadIdx.x & 63, seg = threadIdx.x >> 6;
    float* segP = (float*)lds; float* segH = segP + 8 * 128;
    for (int item = blockIdx.x; item < NB * 8; item += gridDim.x) {
        const int b = item >> 3, ch = (item & 7) * 128 + 2 * lane;
        const int nsteps = seg == 0 ? 272 : 256;
        float P0 = 0.f, P1 = 0.f, H0 = 0.f, H1 = 0.f;
#define rowat(i) ((size_t)(seg == 0 ? ((i) < 16 ? (MREAL + b * 16 + (i)) : (b * SEQ + (i) - 16)) : (b * SEQ + seg * 256 + (i))))
        for (int i0 = 0; i0 < nsteps; i0 += 8) {
            unsigned lw[8], bw[8];
#pragma unroll
            for (int j = 0; j < 8; ++j) { const size_t r = rowat(i0 + j); lw[j] = *(const unsigned*)(la + r * 1024 + ch); bw[j] = *(const unsigned*)(bb + r * 1024 + ch); }
#pragma unroll
            for (int j = 0; j < 8; ++j) { const float l0 = bflo(lw[j]), l1 = bfhi(lw[j]); P0 += l0; P1 += l1; H0 = __expf(l0) * H0 + bflo(bw[j]); H1 = __expf(l1) * H1 + bfhi(bw[j]); }
        }
        __syncthreads();
        segP[seg * 128 + 2 * lane] = P0; segP[seg * 128 + 2 * lane + 1] = P1; segH[seg * 128 + 2 * lane] = H0; segH[seg * 128 + 2 * lane + 1] = H1;
        __syncthreads();
        float h0 = 0.f, h1 = 0.f;
        for (int s = 0; s < seg; ++s) { h0 = __expf(segP[s * 128 + 2 * lane]) * h0 + segH[s * 128 + 2 * lane]; h1 = __expf(segP[s * 128 + 2 * lane + 1]) * h1 + segH[s * 128 + 2 * lane + 1]; }
        for (int i0 = 0; i0 < nsteps; i0 += 8) {
            unsigned lw[8], bw[8], gw[8];
#pragma unroll
            for (int j = 0; j < 8; ++j) { const size_t r = rowat(i0 + j); lw[j] = *(const unsigned*)(la + r * 1024 + ch); bw[j] = *(const unsigned*)(bb + r * 1024 + ch); gw[j] = *(const unsigned*)(proj + r * LD0 + C_LRUG + ch); }
#pragma unroll
            for (int j = 0; j < 8; ++j) {
                h0 = __expf(bflo(lw[j])) * h0 + bflo(bw[j]); h1 = __expf(bfhi(lw[j])) * h1 + bfhi(bw[j]);
                const size_t r = rowat(i0 + j);
                *(unsigned*)(proj + r * LD0 + C_LRUG + ch) = pk2(h0 * siluf_(bflo(gw[j])), h1 * siluf_(bfhi(gw[j])));
            }
        }
    }
#undef rowat
    const float* gsq = (const float*)(ws + OFF_STATS) + MTOT;
    const long total = (long)MTOT * 128;
    for (long it = (long)blockIdx.x * NTHREADS + threadIdx.x; it < total; it += (long)gridDim.x * NTHREADS) {
        const int c = (int)(it & 127); const size_t row = (size_t)(it >> 7);
        const float s = rsqrtf(gsq[row * 2 + (c >> 6)] * (1.f / 512.f) + EPS);
        u32x4* ptr = (u32x4*)(proj + row * LD0 + C_Z + 8 * c);
        const u32x4 q = *ptr; u32x4 o;
        o.x = pk2(bflo(q.x) * s, bfhi(q.x) * s); o.y = pk2(bflo(q.y) * s, bfhi(q.y) * s); o.z = pk2(bflo(q.z) * s, bfhi(q.z) * s); o.w = pk2(bflo(q.w) * s, bfhi(q.w) * s);
        *ptr = o;
    }
}

__device__ __forceinline__ void phase_attn_naive(const Params& p) {
    unsigned char* ws = p.ws;
    const bf16_t* qkvg = (const bf16_t*)(ws + OFF_P0); bf16_t* og = (bf16_t*)(ws + OFF_LA);
    const int lane = threadIdx.x & 63, wave = threadIdx.x >> 6;
    for (int item = blockIdx.x * 8 + wave; item < NB * 16 * 32; item += gridDim.x * 8) {
        const int qb = 31 - (item >> 9), bh = item & 511, b = bh >> 4, h = bh & 15;
        const int u = qb * 64 + lane, t = u + NMETA; const size_t row = (size_t)b * SEQ + u;
        float q[64], o[64];
        { const u32x4* qp = (const u32x4*)(qkvg + row * LD1 + h * 64);
#pragma unroll
          for (int i = 0; i < 8; ++i) { const u32x4 w = qp[i]; q[8 * i] = bflo(w.x); q[8 * i + 1] = bfhi(w.x); q[8 * i + 2] = bflo(w.y); q[8 * i + 3] = bfhi(w.y); q[8 * i + 4] = bflo(w.z); q[8 * i + 5] = bfhi(w.z); q[8 * i + 6] = bflo(w.w); q[8 * i + 7] = bfhi(w.w); } }
#pragma unroll
        for (int d = 0; d < 64; ++d) o[d] = 0.f;
        float R = 0.f;
        const int tmax = qb * 64 + 63 + NMETA;
        for (int s = tmax - 1; s >= 0; --s) {
            const size_t krow = (size_t)rowof(b, s);
            const u32x4* kp = (const u32x4*)(qkvg + krow * LD1 + 1024 + h * 64); const u32x4* vp = (const u32x4*)(qkvg + krow * LD1 + 2048 + h * 64);
            float z = 0.f;
#pragma unroll
            for (int i = 0; i < 8; ++i) { const u32x4 w = kp[i]; z += q[8 * i] * bflo(w.x) + q[8 * i + 1] * bfhi(w.x) + q[8 * i + 2] * bflo(w.y) + q[8 * i + 3] * bfhi(w.y) + q[8 * i + 4] * bflo(w.z) + q[8 * i + 5] * bfhi(w.z) + q[8 * i + 6] * bflo(w.w) + q[8 * i + 7] * bfhi(w.w); }
            z *= 0.125f;
            const bool valid = s < t;
            const float sp = valid ? softplusf_(z) : 0.f;
            R += sp;
            const float wgt = valid ? __expf(z - R) : 0.f;
#pragma unroll
            for (int i = 0; i < 8; ++i) { const u32x4 w = vp[i]; o[8 * i] += wgt * bflo(w.x); o[8 * i + 1] += wgt * bfhi(w.x); o[8 * i + 2] += wgt * bflo(w.y); o[8 * i + 3] += wgt * bfhi(w.y); o[8 * i + 4] += wgt * bflo(w.z); o[8 * i + 5] += wgt * bfhi(w.z); o[8 * i + 6] += wgt * bflo(w.w); o[8 * i + 7] += wgt * bfhi(w.w); }
        }
        const u32x4* gp = (const u32x4*)(qkvg + row * LD1 + 3072 + h * 64); u32x4* op = (u32x4*)(og + row * 1024 + h * 64);
#pragma unroll
        for (int i = 0; i < 8; ++i) { const u32x4 w = gp[i]; u32x4 r;
            r.x = pk2(o[8 * i] * siluf_(bflo(w.x)), o[8 * i + 1] * siluf_(bfhi(w.x))); r.y = pk2(o[8 * i + 2] * siluf_(bflo(w.y)), o[8 * i + 3] * siluf_(bfhi(w.y)));
            r.z = pk2(o[8 * i + 4] * siluf_(bflo(w.z)), o[8 * i + 5] * siluf_(bfhi(w.z))); r.w = pk2(o[8 * i + 6] * siluf_(bflo(w.w)), o[8 * i + 7] * siluf_(bfhi(w.w)));
            op[i] = r; }
    }
}

__device__ __forceinline__ void phase_final(const Params& p) {
    const float* rsq2 = (const float*)(p.ws + OFF_STATS) + 4 * MTOT;
    const long total = (long)MREAL * 256;
    for (long it = (long)blockIdx.x * NTHREADS + threadIdx.x; it < total; it += (long)gridDim.x * NTHREADS) {
        const int c = (int)(it & 255); const size_t row = (size_t)(it >> 8);
        const float s = rsqrtf(rsq2[row] * (1.f / 1024.f) + EPS);
        f32x4* ptr = (f32x4*)(p.out + row * 1024 + 4 * c);
        const f32x4 w = *(const f32x4*)(p.final_norm + 4 * c);
        f32x4 v = *ptr; v = v * s * w; *ptr = v;
    }
}

constexpr int LDS_BYTES = 147456;
__global__ void __launch_bounds__(NTHREADS) fwd_kernel(Params p) {
    extern __shared__ __attribute__((aligned(16))) unsigned char lds_raw[];
    LAS unsigned char* lds = (LAS unsigned char*)lds_raw;
    unsigned char* ws = p.ws;
    const int lo = p.ph_lo, hi = p.ph_hi;
    float* stats = (float*)(ws + OFF_STATS);
#ifndef PHMASK
#define PHMASK 0x3ff
#endif
#define IN(k) (((PHMASK >> (k)) & 1) && lo <= (k) && (k) < hi)
#define SEAM(k) do { if (IN(k) && IN((k) + 1)) { cg::this_grid().sync(); } } while (0)
    if (IN(0)) { phase0(p, lds_raw); }
    SEAM(0);
    if (IN(1)) {
        pg8::Gemm g{(const bf16_t*)(ws + OFF_XB), (const bf16_t*)(ws + OFF_W0T), 1024, 1024, 1024, 0};
        pg8::StaticOrder S; S.init(258, 19, gridDim.x, blockIdx.x);
        pg8::EpiScaleBf16 E{(bf16_t*)(ws + OFF_P0), LD0, stats, EVEN_IN};
        pg8::gemm_phase(lds, g, S, E);
    }
    SEAM(1);
    if (IN(2)) { phase_conv(p); }
    SEAM(2);
    if (IN(3)) {
        pg8::Gemm g{(const bf16_t*)(ws + OFF_XB), (const bf16_t*)(ws + OFF_WGT), 1024, 256, 256, 256};
        pg8::StaticOrder S; S.init(258, 8, gridDim.x, blockIdx.x);
        pg8::EpiGates E{(const bf16_t*)(ws + OFF_XB), p.lru_b_a, p.lru_b_x, stats + 5 * MTOT, (bf16_t*)(ws + OFF_LA), (bf16_t*)(ws + OFF_BB)};
        pg8::gemm_phase(lds, g, S, E);
#ifndef NO_SSD
        phase_ssd_naive(p);
#endif
    }
    SEAM(3);
    if (IN(4)) { phase_scan(p, lds_raw); }
    SEAM(4);
    if (IN(5)) {
        pg8::Gemm g{(const bf16_t*)(ws + OFF_P0) + C_LRUG, (const bf16_t*)(ws + OFF_WO0T), LD0, 2048, 2048, 0};
        pg8::StaticOrder S; S.init(258, 4, gridDim.x, blockIdx.x);
        pg8::EpiOut0 E{p.x, p.meta, (bf16_t*)(ws + OFF_XB), stats + 3 * MTOT};
        pg8::gemm_phase(lds, g, S, E);
    }
    SEAM(5);
    if (IN(6)) {
        pg8::Gemm g{(const bf16_t*)(ws + OFF_XB), (const bf16_t*)(ws + OFF_W1T), 1024, 1024, 1024, 0};
        pg8::StaticOrder S; S.init(258, 16, gridDim.x, blockIdx.x);
        pg8::EpiScaleBf16 E{(bf16_t*)(ws + OFF_P0), LD1, stats + 3 * MTOT, LD1};
        pg8::gemm_phase(lds, g, S, E);
    }
    SEAM(6);
    if (IN(7)) { phase_attn_naive(p); }
    SEAM(7);
    if (IN(8)) {
        pg8::Gemm g{(const bf16_t*)(ws + OFF_LA), (const bf16_t*)(ws + OFF_WO1T), 1024, 1024, 1024, 0};
        pg8::StaticOrder S; S.init(256, 4, gridDim.x, blockIdx.x);
        pg8::EpiOut1 E{(const bf16_t*)(ws + OFF_XB), p.out, stats + 4 * MTOT};
        pg8::gemm_phase(lds, g, S, E);
    }
    SEAM(8);
    if (IN(9)) { phase_final(p); }
#undef IN
#undef SEAM
}

extern "C" void kernel_launch(void* const* d_in, const int* in_sizes, int n_in, void* d_out, int out_size, void* d_ws, size_t ws_size, hipStream_t stream) {
    static int grid = 0;
    if (grid == 0) {
        if (n_in != 22 || ws_size < WS_END) { fprintf(stderr, "kernel_launch: unexpected inputs (n_in %d, ws %zu < %zu)\n", n_in, ws_size, (size_t)WS_END); grid = -1; return; }
        int dev = 0, cus = 0, per_cu = 0;
        hipGetDevice(&dev); hipDeviceGetAttribute(&cus, hipDeviceAttributeMultiprocessorCount, dev);
        hipFuncSetAttribute((const void*)fwd_kernel, hipFuncAttributeMaxDynamicSharedMemorySize, LDS_BYTES);
        hipOccupancyMaxActiveBlocksPerMultiprocessor(&per_cu, (const void*)fwd_kernel, NTHREADS, LDS_BYTES);
        (void)hipGetLastError();
        if (per_cu < 1) per_cu = 1;
        grid = cus * 1;
    }
    if (grid < 0) return;
    Params p{};
    const float** pp = (const float**)&p;
    for (int i = 0; i < 22; ++i) pp[i] = (const float*)d_in[i];
    p.out = (float*)d_out; p.ws = (unsigned char*)d_ws;
#if N_LAUNCH_MODE == 1
    p.ph_lo = 0; p.ph_hi = 10;
    void* args[] = {&p};
    hipError_t e = hipLaunchCooperativeKernel((const void*)fwd_kernel, dim3(grid), dim3(NTHREADS), args, LDS_BYTES, stream);
    if (e != hipSuccess) fprintf(stderr, "cooperative launch failed: %s (grid %d)\n", hipGetErrorString(e), grid);
#else
    for (int ph = 0; ph < 10; ++ph) {
        p.ph_lo = ph; p.ph_hi = ph + 1;
        hipLaunchKernelGGL(fwd_kernel, dim3(grid), dim3(NTHREADS), LDS_BYTES, stream, p);
    }
#endif
}
```

```cpp
#include <hip/hip_runtime.h>
#include <hip/hip_cooperative_groups.h>
#include <cstdint>
#include <cstdio>
namespace cg = cooperative_groups;

#ifndef N_LAUNCH_MODE
#define N_LAUNCH_MODE 1
#endif
#ifndef SSD_NAIVE
#define SSD_NAIVE 0
#endif
#ifndef ATTN_NAIVE
#define ATTN_NAIVE 0
#endif

#define LAS __attribute__((address_space(3)))
typedef unsigned short bf16_t;
typedef short bf16x8 __attribute__((ext_vector_type(8)));
typedef float f32x4 __attribute__((ext_vector_type(4)));
typedef float f32x2 __attribute__((ext_vector_type(2)));
typedef unsigned u32x4 __attribute__((ext_vector_type(4)));
typedef unsigned u32x2 __attribute__((ext_vector_type(2)));
typedef __bf16 bf16x2_t __attribute__((ext_vector_type(2)));

constexpr int NB = 32, SEQ = 2048, NMETA = 16, LL = SEQ + NMETA, DM = 1024;
constexpr int MREAL = NB * SEQ;
constexpr int MTOT = MREAL + NB * NMETA;
constexpr int EVEN_IN = 4624, N0PAD = 4864, LD0 = 4624;
constexpr int C_LRUX = 0, C_LRUG = 1024, C_Z = 2048, C_XBC = 3072, C_DT = 4608;
constexpr int XBCW = 1536;
constexpr int LD1 = 4096;
constexpr float EPS = 1e-6f;
constexpr int NTHREADS = 512;

constexpr size_t MiB = 1u << 20;
constexpr size_t OFF_W0T = 0;
constexpr size_t OFF_WGT = 10 * MiB;
constexpr size_t OFF_WO0T = 11 * MiB;
constexpr size_t OFF_W1T = 15 * MiB;
constexpr size_t OFF_WO1T = 23 * MiB;
constexpr size_t OFF_STATS = 25 * MiB;
constexpr size_t OFF_XB = 27 * MiB;
constexpr size_t SZ_ACT = (size_t)MTOT * 1024 * 2;
constexpr size_t OFF_P0 = OFF_XB + SZ_ACT;
constexpr size_t SZ_P0 = (size_t)MTOT * LD0 * 2;
constexpr size_t OFF_LA = OFF_P0 + SZ_P0;
constexpr size_t OFF_BB = OFF_LA + SZ_ACT;
constexpr size_t WS_END = OFF_BB + SZ_ACT;
static_assert(WS_END <= (size_t)1024 * MiB, "workspace map");

struct Params {
    const float* x; const float* meta; const float* even_norm; const float* even_w_in;
    const float* lru_conv_w; const float* lru_conv_b; const float* lru_w_a; const float* lru_b_a;
    const float* lru_w_x; const float* lru_b_x; const float* lru_lambda; const float* ssd_conv_w;
    const float* ssd_conv_b; const float* ssd_dt_bias; const float* ssd_a_log; const float* ssd_d;
    const float* ssd_norm; const float* even_w_out; const float* odd_norm; const float* odd_w_in;
    const float* odd_w_out; const float* final_norm;
    float* out; unsigned char* ws;
    int ph_lo, ph_hi;
};

__device__ __forceinline__ unsigned pk2(float lo, float hi) { f32x2 v = {lo, hi}; bf16x2_t b = __builtin_convertvector(v, bf16x2_t); return __builtin_bit_cast(unsigned, b); }
__device__ __forceinline__ float bflo(unsigned w) { return __uint_as_float(w << 16); }
__device__ __forceinline__ float bfhi(unsigned w) { return __uint_as_float(w & 0xffff0000u); }
__device__ __forceinline__ float bf2f(bf16_t h) { return __uint_as_float((unsigned)h << 16); }
__device__ __forceinline__ bf16_t f2bf(float f) { return (bf16_t)(pk2(f, 0.f) & 0xffffu); }
__device__ __forceinline__ int rowof(int b, int t) { return t >= NMETA ? b * SEQ + (t - NMETA) : MREAL + b * NMETA + t; }
__device__ __forceinline__ float sigmoidf_(float v) { return 1.f / (1.f + __expf(-v)); }
__device__ __forceinline__ float siluf_(float v) { return v / (1.f + __expf(-v)); }
__device__ __forceinline__ float softplusf_(float v) { return fmaxf(v, 0.f) + log1pf(__expf(-fabsf(v))); }
__device__ __forceinline__ float wave_sum(float v) {
#pragma unroll
    for (int o = 1; o < 64; o <<= 1) v += __shfl_xor(v, o);
    return v;
}

namespace pg8 {
constexpr int BM = 256, BK = 64, HALF = 128, HTB = HALF * BK * 2, STAGE_BYTES = 8 * HTB, NXCD = 8, WGM = 8;
__host__ __device__ __forceinline__ int lds_byte(int r, int c) { const int st = (r >> 4) * 2 + (c >> 5), rr = r & 15, cc = c & 31, ob = rr * 64 + cc * 2; return st * 1024 + (ob ^ (((ob >> 9) & 1) << 5)); }
__host__ __device__ __forceinline__ void stage_rc(int b, int& R, int& C) { const int st = b / 1024, sb = b % 1024, swz = sb ^ (((sb >> 9) & 1) << 5); R = (st >> 1) * 16 + swz / 64; C = (st & 1) * 32 + (swz % 64) / 2; }
__host__ __device__ __forceinline__ int perm32(int rho) { const int n = rho >> 4, i = rho & 15; return 8 * (i >> 2) + 4 * n + (i & 3); }

struct Unit { int pm, pn; };
struct Gemm { const bf16_t* A; const bf16_t* Bt; int lda, ldb, K, agrp; };
struct StaticOrder {
    int nM, nN, nwg, G, c;
    __device__ void init(int nM_, int nN_, int G_, int c_) { nM = nM_; nN = nN_; nwg = nM * nN; G = G_; c = c_; }
    __device__ bool next(int i, Unit& u) const {
        const long L = (long)i * G + c; if (L >= nwg) return false;
        int wgid = (int)L; { const int q = nwg / NXCD, r = nwg % NXCD, xcd = wgid % NXCD, off = wgid / NXCD; wgid = (xcd < r ? xcd * (q + 1) : r * (q + 1) + (xcd - r) * q) + off; }
        const int nig = WGM * nN, gid = wgid / nig, fm = gid * WGM, gsz = (nM - fm) < WGM ? (nM - fm) : WGM;
        u.pm = fm + ((wgid % nig) % gsz); u.pn = (wgid % nig) / gsz; return true;
    }
};

struct EpiScaleBf16 {
    static constexpr bool PERM = true;
    bf16_t* O; int ldc; const float* rsq; int ncols;
    __device__ __forceinline__ void operator()(const f32x4 (&acc)[2][2][4][2], const Unit& u, int wr, int wc, int fr, int fq) const {
        const int row0 = u.pm * BM + wr * 64 + fr, col0 = u.pn * BM + wc * 32 + 8 * fq;
#pragma unroll
        for (int ai = 0; ai < 2; ++ai)
#pragma unroll
            for (int m = 0; m < 4; ++m) {
                const int row = row0 + ai * HALF + m * 16;
                const float s = rsqrtf(rsq[row] * (1.f / 1024.f) + EPS);
                bf16_t* rowp = O + (size_t)row * ldc + col0;
#pragma unroll
                for (int bj = 0; bj < 2; ++bj) {
                    if (col0 + bj * HALF < ncols) {
                        const f32x4 v0 = acc[ai][bj][m][0] * s, v1 = acc[ai][bj][m][1] * s;
                        u32x4 w; w.x = pk2(v0[0], v0[1]); w.y = pk2(v0[2], v0[3]); w.z = pk2(v1[0], v1[1]); w.w = pk2(v1[2], v1[3]);
                        *(u32x4*)(rowp + bj * HALF) = w;
                    }
                }
            }
    }
};
struct EpiGates {
    static constexpr bool PERM = false;
    const bf16_t* lx; const float* b_a; const float* b_x; const float* lam; bf16_t* la; bf16_t* bb;
    __device__ __forceinline__ void operator()(const f32x4 (&acc)[2][2][4][2], const Unit& u, int wr, int wc, int fr, int fq) const {
        const int row0 = u.pm * BM + wr * 64 + fr;
        const int ch0 = (u.pn >> 1) * 256 + (u.pn & 1) * 128 + wc * 32 + 4 * fq;
#pragma unroll
        for (int ai = 0; ai < 2; ++ai)
#pragma unroll
            for (int m = 0; m < 4; ++m) {
                const int row = row0 + ai * HALF + m * 16;
#pragma unroll
                for (int n = 0; n < 2; ++n) {
                    const int ch = ch0 + 16 * n;
                    const f32x4 ba = *(const f32x4*)(b_a + ch), bx = *(const f32x4*)(b_x + ch), cneg = *(const f32x4*)(lam + ch);
                    const u32x2 lw = *(const u32x2*)(lx + (size_t)row * 1024 + ch);
                    const float lxv[4] = {bflo(lw.x), bfhi(lw.x), bflo(lw.y), bfhi(lw.y)};
                    float lo[4], bo[4];
#pragma unroll
                    for (int j = 0; j < 4; ++j) {
                        const float r = sigmoidf_(acc[ai][0][m][n][j] + ba[j]);
                        const float ig = sigmoidf_(acc[ai][1][m][n][j] + bx[j]);
                        const float loga = cneg[j] * r;
                        const float a2 = __expf(2.f * loga);
                        lo[j] = loga; bo[j] = sqrtf(fmaxf(1.f - a2, 0.f)) * ig * lxv[j];
                    }
                    u32x2 w0; w0.x = pk2(lo[0], lo[1]); w0.y = pk2(lo[2], lo[3]);
                    u32x2 w1; w1.x = pk2(bo[0], bo[1]); w1.y = pk2(bo[2], bo[3]);
                    *(u32x2*)(la + (size_t)row * 1024 + ch) = w0;
                    *(u32x2*)(bb + (size_t)row * 1024 + ch) = w1;
                    asm volatile("" ::: "memory");
                }
            }
    }
};
struct EpiOut0 {
    static constexpr bool PERM = false;
    const float* x; const float* meta; bf16_t* h1b; float* rsq;
    __device__ __forceinline__ void operator()(const f32x4 (&acc)[2][2][4][2], const Unit& u, int wr, int wc, int fr, int fq) const {
        const int row0 = u.pm * BM + wr * 64 + fr, col0 = u.pn * BM + wc * 32 + 4 * fq;
#pragma unroll
        for (int ai = 0; ai < 2; ++ai)
#pragma unroll
            for (int m = 0; m < 4; ++m) {
                const int row = row0 + ai * HALF + m * 16;
                const float* src = row < MREAL ? x + (size_t)row * 1024 : meta + (size_t)((row - MREAL) & 15) * 1024;
                float ss = 0.f;
#pragma unroll
                for (int bj = 0; bj < 2; ++bj)
#pragma unroll
                    for (int n = 0; n < 2; ++n) {
                        const int col = col0 + bj * HALF + n * 16;
                        const f32x4 v = acc[ai][bj][m][n] + *(const f32x4*)(src + col);
                        ss += (v[0] * v[0] + v[1] * v[1]) + (v[2] * v[2] + v[3] * v[3]);
                        u32x2 w; w.x = pk2(v[0], v[1]); w.y = pk2(v[2], v[3]);
                        *(u32x2*)(h1b + (size_t)row * 1024 + col) = w;
                    }
                ss += __shfl_xor(ss, 16); ss += __shfl_xor(ss, 32);
                if (fq == 0) atomicAdd(rsq + row, ss);
            }
    }
};
struct EpiOut1 {
    static constexpr bool PERM = false;
    const bf16_t* h1b; float* out; float* rsq;
    __device__ __forceinline__ void operator()(const f32x4 (&acc)[2][2][4][2], const Unit& u, int wr, int wc, int fr, int fq) const {
        const int row0 = u.pm * BM + wr * 64 + fr, col0 = u.pn * BM + wc * 32 + 4 * fq;
#pragma unroll
        for (int ai = 0; ai < 2; ++ai)
#pragma unroll
            for (int m = 0; m < 4; ++m) {
                const int row = row0 + ai * HALF + m * 16;
                float ss = 0.f;
#pragma unroll
                for (int bj = 0; bj < 2; ++bj)
#pragma unroll
                    for (int n = 0; n < 2; ++n) {
                        const int col = col0 + bj * HALF + n * 16;
                        const u32x2 hw = *(const u32x2*)(h1b + (size_t)row * 1024 + col);
                        f32x4 v = acc[ai][bj][m][n];
                        v[0] += bflo(hw.x); v[1] += bfhi(hw.x); v[2] += bflo(hw.y); v[3] += bfhi(hw.y);
                        ss += (v[0] * v[0] + v[1] * v[1]) + (v[2] * v[2] + v[3] * v[3]);
                        *(f32x4*)(out + (size_t)row * 1024 + col) = v;
                    }
                ss += __shfl_xor(ss, 16); ss += __shfl_xor(ss, 32);
                if (fq == 0) atomicAdd(rsq + row, ss);
            }
    }
};

template <class Epi, class Sched>
__device__ __forceinline__ void gemm_phase(LAS unsigned char* lds, const Gemm g, const Sched& S, const Epi& E) {
    const int tid = threadIdx.x, wid = __builtin_amdgcn_readfirstlane(tid >> 6), lane = tid & 63, wr = wid >> 2, wc = wid & 3, fr = lane & 15, fq = lane >> 4;
    const int K = g.K, nt = K / BK;
    unsigned voffA[2], voffB[2];
#pragma unroll
    for (int i = 0; i < 2; ++i) { int R, C; stage_rc(tid * 16 + i * 8192, R, C); const int Rb = Epi::PERM ? ((R & ~31) + perm32(R & 31)) : R;
        voffA[i] = (unsigned)(R * g.lda + C) * 2u; voffB[i] = (unsigned)(Rb * g.ldb + C) * 2u; }
    const size_t kstep = (size_t)(BK * 2);
    const size_t hstepA = (size_t)HALF * g.lda * 2, hstepB = (size_t)HALF * g.ldb * 2;
    const size_t tstepA = 2 * hstepA, tstepB = 2 * hstepB;
    const unsigned ldsw = (unsigned)wid * 1024u;
    const int aoff = lds_byte(wr * 64 + fr, fq * 8), boff = lds_byte(wc * 32 + fr, fq * 8);
#define PG8_SA(b, h) (((b) * 2 + (h)) * HTB)
#define PG8_SB(b, h) ((4 + (b) * 2 + (h)) * HTB)
#define PG8_STAGE(bufoff, gbase, voff) do { _Pragma("unroll") for (int _i = 0; _i < 2; ++_i) \
        __builtin_amdgcn_global_load_lds((const unsigned*)((const char*)(gbase) + (voff)[_i]), (LAS unsigned*)(lds + (bufoff) + ldsw + _i * 8192), 16, 0, 0); } while (0)
#define PG8_LDA(dst, b, h) do { _Pragma("unroll") for (int m = 0; m < 4; ++m) _Pragma("unroll") for (int k = 0; k < 2; ++k) dst[m][k] = *(const LAS bf16x8*)(lds + PG8_SA(b, h) + aoff + m * 2048 + k * 1024); } while (0)
#define PG8_LDB(dst, b, h) do { _Pragma("unroll") for (int n = 0; n < 2; ++n) _Pragma("unroll") for (int k = 0; k < 2; ++k) dst[n][k] = *(const LAS bf16x8*)(lds + PG8_SB(b, h) + boff + n * 2048 + k * 1024); } while (0)
#define PG8_MMA(ai, bj, At, Bt) do { __builtin_amdgcn_s_setprio(1); _Pragma("unroll") for (int m = 0; m < 4; ++m) _Pragma("unroll") for (int n = 0; n < 2; ++n) _Pragma("unroll") for (int k = 0; k < 2; ++k) \
        acc[ai][bj][m][n] = __builtin_amdgcn_mfma_f32_16x16x32_bf16(Bt[n][k], At[m][k], acc[ai][bj][m][n], 0, 0, 0); __builtin_amdgcn_s_setprio(0); } while (0)
#define PG8_WAIT_V(n) asm volatile("s_waitcnt vmcnt(" #n ")" ::: "memory")
#define PG8_WAIT_L(n) asm volatile("s_waitcnt lgkmcnt(" #n ")" ::: "memory")
#define PG8_BAR __builtin_amdgcn_s_barrier()
#define PG8_SCHED __builtin_amdgcn_sched_barrier(0)
    Unit cur, nxt; int ui = 0;
    if (!S.next(0, cur)) return;
    f32x4 acc[2][2][4][2];
#pragma unroll
    for (int a = 0; a < 2; ++a)
#pragma unroll
        for (int b = 0; b < 2; ++b)
#pragma unroll
            for (int m = 0; m < 4; ++m)
#pragma unroll
                for (int n = 0; n < 2; ++n) acc[a][b][m][n] = (f32x4){0.f, 0.f, 0.f, 0.f};
    bf16x8 At[4][2], B0[2][2], B1[2][2];
    const char* cA = (const char*)g.A + (size_t)cur.pm * tstepA + (size_t)((cur.pn >> 1) * g.agrp) * 2; const char* cB = (const char*)g.Bt + (size_t)cur.pn * tstepB;
    PG8_STAGE(PG8_SB(0, 0), cB, voffB); PG8_STAGE(PG8_SB(0, 1), cB + hstepB, voffB); PG8_STAGE(PG8_SA(0, 0), cA, voffA); PG8_STAGE(PG8_SA(0, 1), cA + hstepA, voffA);
    if (wr == 1) PG8_BAR;
    PG8_WAIT_V(2); PG8_BAR;
    PG8_STAGE(PG8_SB(1, 0), cB + kstep, voffB); PG8_STAGE(PG8_SA(1, 0), cA + kstep, voffA); PG8_STAGE(PG8_SB(1, 1), cB + hstepB + kstep, voffB);
    PG8_WAIT_V(6); PG8_BAR;
    for (;;) {
        const bool has_next = S.next(ui + 1, nxt);
        const char* nA = has_next ? (const char*)g.A + (size_t)nxt.pm * tstepA + (size_t)((nxt.pn >> 1) * g.agrp) * 2 : cA; const char* nB = has_next ? (const char*)g.Bt + (size_t)nxt.pn * tstepB : cB;
        for (int t = 0; t < nt; t += 2) {
            const bool last = (t == nt - 2);
            const char* a1 = cA + (size_t)(t + 1) * kstep;
            const char* a2 = last ? nA : cA + (size_t)(t + 2) * kstep; const char* b2 = last ? nB : cB + (size_t)(t + 2) * kstep;
            const char* a3 = a2 + kstep; const char* b3 = b2 + kstep;
            PG8_LDB(B0, 0, 0); PG8_LDB(B1, 0, 1); PG8_SCHED; PG8_LDA(At, 0, 0); PG8_STAGE(PG8_SA(1, 1), a1 + hstepA, voffA);
            PG8_WAIT_V(8); PG8_WAIT_L(0); PG8_BAR; PG8_MMA(0, 0, At, B0); PG8_MMA(0, 1, At, B1); PG8_BAR; PG8_SCHED;
            PG8_LDA(At, 0, 1); PG8_STAGE(PG8_SB(0, 0), b2, voffB); PG8_STAGE(PG8_SB(0, 1), b2 + hstepB, voffB); PG8_STAGE(PG8_SA(0, 0), a2, voffA);
            PG8_WAIT_V(8); PG8_WAIT_L(0); PG8_BAR; PG8_MMA(1, 0, At, B0); PG8_MMA(1, 1, At, B1); PG8_BAR; PG8_SCHED;
            PG8_LDB(B0, 1, 0); PG8_LDB(B1, 1, 1); PG8_SCHED; PG8_LDA(At, 1, 0); PG8_STAGE(PG8_SA(0, 1), a2 + hstepA, voffA);
            PG8_WAIT_V(8); PG8_WAIT_L(0); PG8_BAR; PG8_MMA(0, 0, At, B0); PG8_MMA(0, 1, At, B1); PG8_BAR; PG8_SCHED;
            PG8_LDA(At, 1, 1); PG8_STAGE(PG8_SB(1, 0), b3, voffB); PG8_STAGE(PG8_SB(1, 1), b3 + hstepB, voffB); PG8_STAGE(PG8_SA(1, 0), a3, voffA);
            PG8_WAIT_V(8); PG8_WAIT_L(0); PG8_BAR; PG8_MMA(1, 0, At, B0); PG8_MMA(1, 1, At, B1); PG8_BAR; PG8_SCHED;
        }
        if (wr == 0) PG8_BAR;
        E(acc, cur, wr, wc, fr, fq);
        if (!has_next) break;
#pragma unroll
        for (int a = 0; a < 2; ++a)
#pragma unroll
            for (int b = 0; b < 2; ++b)
#pragma unroll
                for (int m = 0; m < 4; ++m)
#pragma unroll
                    for (int n = 0; n < 2; ++n) acc[a][b][m][n] = (f32x4){0.f, 0.f, 0.f, 0.f};
        cur = nxt; cA = nA; cB = nB; ++ui;
        if (wr == 1) PG8_BAR;
    }
    PG8_WAIT_V(0);
    PG8_BAR;
#undef PG8_SA
#undef PG8_SB
#undef PG8_STAGE
#undef PG8_LDA
#undef PG8_LDB
#undef PG8_MMA
#undef PG8_WAIT_V
#undef PG8_WAIT_L
#undef PG8_BAR
#undef PG8_SCHED
}
}

__device__ __forceinline__ void transpose_tile(const float* src, int src_ld, int n_valid, int k0, int n0, bf16_t* dst, int dst_ld, int dst_row0, const float* kscale, float* scr, int lane) {
#pragma unroll 8
    for (int i = 0; i < 32; ++i) {
        const int kk = 2 * i + (lane >> 5), n = n0 + (lane & 31);
        float v = n < n_valid ? src[(size_t)(k0 + kk) * src_ld + n] : 0.f;
        if (kscale) v *= kscale[k0 + kk];
        scr[kk * 33 + (lane & 31)] = v;
    }
    asm volatile("s_waitcnt lgkmcnt(0)" ::: "memory");
    const int c = lane & 7;
#pragma unroll
    for (int j = 0; j < 4; ++j) {
        const int n = (lane >> 3) + 8 * j; const float* s = scr + (8 * c) * 33 + n;
        u32x4 o; o.x = pk2(s[0 * 33], s[1 * 33]); o.y = pk2(s[2 * 33], s[3 * 33]); o.z = pk2(s[4 * 33], s[5 * 33]); o.w = pk2(s[6 * 33], s[7 * 33]);
        *(u32x4*)(dst + (size_t)(dst_row0 + n) * dst_ld + k0 + 8 * c) = o;
    }
    asm volatile("s_waitcnt lgkmcnt(0)" ::: "memory");
}

__device__ __forceinline__ void phase0(const Params& p, unsigned char* lds) {
    unsigned char* ws = p.ws;
    const int tid = threadIdx.x, lane = tid & 63, wave = tid >> 6;
    const int gw = blockIdx.x * 8 + wave, NGW = gridDim.x * 8;
    float* scr = (float*)(lds + wave * 16384);
    bf16_t* W0T = (bf16_t*)(ws + OFF_W0T); bf16_t* WGT = (bf16_t*)(ws + OFF_WGT); bf16_t* WO0T = (bf16_t*)(ws + OFF_WO0T);
    bf16_t* W1T = (bf16_t*)(ws + OFF_W1T); bf16_t* WO1T = (bf16_t*)(ws + OFF_WO1T);
    constexpr int I_W0 = 16 * 152, I_G = 256, I_O0 = 32 * 32, I_W1 = 16 * 128, I_O1 = 16 * 32;
    constexpr int NIT = I_W0 + I_G + I_O0 + I_W1 + I_O1;
    for (int it = gw; it < NIT; it += NGW) {
        int r = it;
        if (r < I_W0) { const int kb = r / 152, nb = r % 152; transpose_tile(p.even_w_in, EVEN_IN, EVEN_IN, 64 * kb, 32 * nb, W0T, 1024, 32 * nb, p.even_norm, scr, lane); continue; }
        r -= I_W0;
        if (r < I_G) {
            const int nb = r & 3, kb = (r >> 2) & 3, tp = (r >> 4) & 1, which = (r >> 5) & 1, g = r >> 6;
            const float* src = (which ? p.lru_w_x : p.lru_w_a) + (size_t)g * 65536;
            transpose_tile(src, 256, 256, 64 * kb, 128 * tp + 32 * nb, WGT, 256, (2 * g + tp) * 256 + which * 128 + 32 * nb, nullptr, scr, lane); continue; }
        r -= I_G;
        if (r < I_O0) { const int kb = r / 32, nb = r % 32;
            transpose_tile(p.even_w_out, 1024, 1024, 64 * kb, 32 * nb, WO0T, 2048, 32 * nb, kb >= 16 ? p.ssd_norm - 1024 : nullptr, scr, lane); continue; }
        r -= I_O0;
        if (r < I_W1) { const int kb = r / 128, nb = r % 128; transpose_tile(p.odd_w_in, 4096, 4096, 64 * kb, 32 * nb, W1T, 1024, 32 * nb, p.odd_norm, scr, lane); continue; }
        r -= I_W1;
        { const int kb = r / 32, nb = r % 32; transpose_tile(p.odd_w_out, 1024, 1024, 64 * kb, 32 * nb, WO1T, 1024, 32 * nb, nullptr, scr, lane); }
    }
    bf16_t* xb = (bf16_t*)(ws + OFF_XB); float* stats = (float*)(ws + OFF_STATS);
    for (int m = gw; m < MTOT; m += NGW) {
        const float* src = m < MREAL ? p.x + (size_t)m * 1024 : p.meta + (size_t)((m - MREAL) & 15) * 1024;
        const f32x4* xr = (const f32x4*)src + lane; float s = 0.f;
        unsigned long long* o8 = (unsigned long long*)(xb + (size_t)m * 1024) + lane;
#pragma unroll
        for (int j = 0; j < 4; ++j) { const f32x4 v = xr[64 * j]; s += (v[0] * v[0] + v[1] * v[1]) + (v[2] * v[2] + v[3] * v[3]);
            o8[64 * j] = (unsigned long long)pk2(v[0], v[1]) | ((unsigned long long)pk2(v[2], v[3]) << 32); }
        s = wave_sum(s);
        if (lane == 0) stats[m] = s;
    }
    if (blockIdx.x == 0) for (int i = tid; i < 1024; i += NTHREADS) stats[5 * MTOT + i] = -8.f * log1pf(__expf(-p.lru_lambda[i]));
    for (int i = blockIdx.x * NTHREADS + tid; i < 4 * MTOT; i += gridDim.x * NTHREADS) stats[MTOT + i] = 0.f;
}

__device__ __forceinline__ void phase_conv(const Params& p) {
    unsigned char* ws = p.ws;
    const bf16_t* proj = (const bf16_t*)(ws + OFF_P0);
    bf16_t* lx = (bf16_t*)(ws + OFF_XB); bf16_t* xc = (bf16_t*)p.out;
    constexpr int NCH = 320, NTB = LL / 16;
    const long total = (long)NB * NTB * NCH;
    for (long it = (long)blockIdx.x * NTHREADS + threadIdx.x; it < total; it += (long)gridDim.x * NTHREADS) {
        const int c = (int)(it % NCH); const int tb = (int)((it / NCH) % NTB); const int b = (int)(it / ((long)NCH * NTB));
        const bool is_lru = c < 128;
        const int scol = is_lru ? 8 * c : C_XBC + 8 * (c - 128);
        const int wcol = is_lru ? 8 * c : 8 * (c - 128);
        const float* cw = is_lru ? p.lru_conv_w : p.ssd_conv_w; const int cwld = is_lru ? 1024 : XBCW;
        const float* cb = is_lru ? p.lru_conv_b : p.ssd_conv_b;
        float w[4][8], bias[8];
#pragma unroll
        for (int j = 0; j < 4; ++j) { const f32x4 a = *(const f32x4*)(cw + j * cwld + wcol), bq = *(const f32x4*)(cw + j * cwld + wcol + 4);
            w[j][0] = a[0]; w[j][1] = a[1]; w[j][2] = a[2]; w[j][3] = a[3]; w[j][4] = bq[0]; w[j][5] = bq[1]; w[j][6] = bq[2]; w[j][7] = bq[3]; }
        { const f32x4 a = *(const f32x4*)(cb + wcol), bq = *(const f32x4*)(cb + wcol + 4);
            bias[0] = a[0]; bias[1] = a[1]; bias[2] = a[2]; bias[3] = a[3]; bias[4] = bq[0]; bias[5] = bq[1]; bias[6] = bq[2]; bias[7] = bq[3]; }
        float h0[8], h1[8], h2[8];
        const int t0 = tb * 16;
#define LOADROW(dst, tt) do { if ((tt) >= 0) { const u32x4 q = *(const u32x4*)(proj + (size_t)rowof(b, (tt)) * LD0 + scol); \
            dst[0] = bflo(q.x); dst[1] = bfhi(q.x); dst[2] = bflo(q.y); dst[3] = bfhi(q.y); dst[4] = bflo(q.z); dst[5] = bfhi(q.z); dst[6] = bflo(q.w); dst[7] = bfhi(q.w); } \
            else { _Pragma("unroll") for (int e = 0; e < 8; ++e) dst[e] = 0.f; } } while (0)
        LOADROW(h0, t0 - 3); LOADROW(h1, t0 - 2); LOADROW(h2, t0 - 1);
#pragma unroll 4
        for (int i = 0; i < 16; ++i) {
            const int t = t0 + i; float cur[8]; LOADROW(cur, t);
            float o[8];
#pragma unroll
            for (int e = 0; e < 8; ++e) { float v = bias[e] + w[0][e] * h0[e] + w[1][e] * h1[e] + w[2][e] * h2[e] + w[3][e] * cur[e]; o[e] = is_lru ? v : siluf_(v); h0[e] = h1[e]; h1[e] = h2[e]; h2[e] = cur[e]; }
            u32x4 q; q.x = pk2(o[0], o[1]); q.y = pk2(o[2], o[3]); q.z = pk2(o[4], o[5]); q.w = pk2(o[6], o[7]);
            const size_t row = (size_t)rowof(b, t);
            if (is_lru) *(u32x4*)(lx + row * 1024 + wcol) = q; else *(u32x4*)(xc + row * XBCW + wcol) = q;
        }
#undef LOADROW
    }
}

__device__ __forceinline__ void phase_ssd_naive(const Params& p) {
    unsigned char* ws = p.ws;
    bf16_t* proj = (bf16_t*)(ws + OFF_P0); const bf16_t* xc = (const bf16_t*)p.out; float* gsq = (float*)(ws + OFF_STATS) + MTOT;
    const int lane = threadIdx.x & 63, wave = threadIdx.x >> 6;
    for (int item = blockIdx.x * 8 + wave; item < NB * 16 * 2; item += gridDim.x * 8) {
        const int b = item >> 5, h = (item >> 1) & 15, ph = item & 1, g = h >> 3;
        const int pp = ph * 32 + (lane & 31), nh = lane >> 5;
        const float dtb = p.ssd_dt_bias[h], a = -__expf(p.ssd_a_log[h]), dsk = p.ssd_d[h];
        float st[64];
#pragma unroll
        for (int n = 0; n < 64; ++n) st[n] = 0.f;
        for (int t = 0; t < LL; ++t) {
            const size_t row = (size_t)rowof(b, t);
            const float xv = bf2f(xc[row * XBCW + h * 64 + pp]);
            const float dt = softplusf_(bf2f(proj[row * LD0 + C_DT + h]) + dtb);
            const float dA = __expf(dt * a), dx = dt * xv;
            const u32x4* Bp = (const u32x4*)(xc + row * XBCW + 1024 + g * 128 + nh * 64); const u32x4* Cp = (const u32x4*)(xc + row * XBCW + 1280 + g * 128 + nh * 64);
            float y = 0.f;
#pragma unroll
            for (int q = 0; q < 8; ++q) {
                const u32x4 bw = Bp[q], cw = Cp[q];
                const float bv[8] = {bflo(bw.x), bfhi(bw.x), bflo(bw.y), bfhi(bw.y), bflo(bw.z), bfhi(bw.z), bflo(bw.w), bfhi(bw.w)};
                const float cv[8] = {bflo(cw.x), bfhi(cw.x), bflo(cw.y), bfhi(cw.y), bflo(cw.z), bfhi(cw.z), bflo(cw.w), bfhi(cw.w)};
#pragma unroll
                for (int e = 0; e < 8; ++e) { st[q * 8 + e] = dA * st[q * 8 + e] + dx * bv[e]; y += cv[e] * st[q * 8 + e]; }
            }
            y += __shfl_xor(y, 32);
            y += dsk * xv;
            const float z = bf2f(proj[row * LD0 + C_Z + h * 64 + pp]);
            const float gv = y * siluf_(z);
            if (nh == 0) proj[row * LD0 + C_Z + h * 64 + pp] = f2bf(gv);
            const float ss = wave_sum(nh == 0 ? gv * gv : 0.f);
            if (lane == 0) atomicAdd(gsq + row * 2 + g, ss);
        }
    }
}

__device__ __forceinline__ void phase_scan(const Params& p, unsigned char* lds) {
    unsigned char* ws = p.ws;
    bf16_t* proj = (bf16_t*)(ws + OFF_P0); const bf16_t* la = (const bf16_t*)(ws + OFF_LA); const bf16_t* bb = (const bf16_t*)(ws + OFF_BB);
    const int lane = threadIdx.x & 63, seg = threadIdx.x >> 6;
    float* segP = (float*)lds; float* segH = segP + 8 * 128;
    for (int item = blockIdx.x; item < NB * 8; item += gridDim.x) {
        const int b = item >> 3, ch = (item & 7) * 128 + 2 * lane;
        const int nsteps = seg == 0 ? 272 : 256;
        float P0 = 0.f, P1 = 0.f, H0 = 0.f, H1 = 0.f;
#define rowat(i) ((size_t)(seg == 0 ? ((i) < 16 ? (MREAL + b * 16 + (i)) : (b * SEQ + (i) - 16)) : (b * SEQ + seg * 256 + (i))))
        for (int i0 = 0; i0 < nsteps; i0 += 8) {
            unsigned lw[8], bw[8];
#pragma unroll
            for (int j = 0; j < 8; ++j) { const size_t r = rowat(i0 + j); lw[j] = *(const unsigned*)(la + r * 1024 + ch); bw[j] = *(const unsigned*)(bb + r * 1024 + ch); }
#pragma unroll
            for (int j = 0; j < 8; ++j) { const float l0 = bflo(lw[j]), l1 = bfhi(lw[j]); P0 += l0; P1 += l1; H0 = __expf(l0) * H0 + bflo(bw[j]); H1 = __expf(l1) * H1 + bfhi(bw[j]); }
        }
        __syncthreads();
        segP[seg * 128 + 2 * lane] = P0; segP[seg * 128 + 2 * lane + 1] = P1; segH[seg * 128 + 2 * lane] = H0; segH[seg * 128 + 2 * lane + 1] = H1;
        __syncthreads();
        float h0 = 0.f, h1 = 0.f;
        for (int s = 0; s < seg; ++s) { h0 = __expf(segP[s * 128 + 2 * lane]) * h0 + segH[s * 128 + 2 * lane]; h1 = __expf(segP[s * 128 + 2 * lane + 1]) * h1 + segH[s * 128 + 2 * lane + 1]; }
        for (int i0 = 0; i0 < nsteps; i0 += 8) {
            unsigned lw[8], bw[8], gw[8];
#pragma unroll
            for (int j = 0; j < 8; ++j) { const size_t r = rowat(i0 + j); lw[j] = *(const unsigned*)(la + r * 1024 + ch); bw[j] = *(const unsigned*)(bb + r * 1024 + ch); gw[j] = *(const unsigned*)(proj + r * LD0 + C_LRUG + ch); }
#pragma unroll
            for (int j = 0; j < 8; ++j) {
                h0 = __expf(bflo(lw[j])) * h0 + bflo(bw[j]); h1 = __expf(bfhi(lw[j])) * h1 + bfhi(bw[j]);
                const size_t r = rowat(i0 + j);
                *(unsigned*)(proj + r * LD0 + C_LRUG + ch) = pk2(h0 * siluf_(bflo(gw[j])), h1 * siluf_(bfhi(gw[j])));
            }
        }
    }
#undef rowat
    const float* gsq = (const float*)(ws + OFF_STATS) + MTOT;
    const long total = (long)MTOT * 128;
    for (long it = (long)blockIdx.x * NTHREADS + threadIdx.x; it < total; it += (long)gridDim.x * NTHREADS) {
        const int c = (int)(it & 127); const size_t row = (size_t)(it >> 7);
        const float s = rsqrtf(gsq[row * 2 + (c >> 6)] * (1.f / 512.f) + EPS);
        u32x4* ptr = (u32x4*)(proj + row * LD0 + C_Z + 8 * c);
        const u32x4 q = *ptr; u32x4 o;
        o.x = pk2(bflo(q.x) * s, bfhi(q.x) * s); o.y = pk2(bflo(q.y) * s, bfhi(q.y) * s); o.z = pk2(bflo(q.z) * s, bfhi(q.z) * s); o.w = pk2(bflo(q.w) * s, bfhi(q.w) * s);
        *ptr = o;
    }
}

__device__ __forceinline__ void phase_attn_naive(const Params& p) {
    unsigned char* ws = p.ws;
    const bf16_t* qkvg = (const bf16_t*)(ws + OFF_P0); bf16_t* og = (bf16_t*)(ws + OFF_LA);
    const int lane = threadIdx.x & 63, wave = threadIdx.x >> 6;
    for (int item = blockIdx.x * 8 + wave; item < NB * 16 * 32; item += gridDim.x * 8) {
        const int qb = 31 - (item >> 9), bh = item & 511, b = bh >> 4, h = bh & 15;
        const int u = qb * 64 + lane, t = u + NMETA; const size_t row = (size_t)b * SEQ + u;
        float q[64], o[64];
        { const u32x4* qp = (const u32x4*)(qkvg + row * LD1 + h * 64);
#pragma unroll
          for (int i = 0; i < 8; ++i) { const u32x4 w = qp[i]; q[8 * i] = bflo(w.x); q[8 * i + 1] = bfhi(w.x); q[8 * i + 2] = bflo(w.y); q[8 * i + 3] = bfhi(w.y); q[8 * i + 4] = bflo(w.z); q[8 * i + 5] = bfhi(w.z); q[8 * i + 6] = bflo(w.w); q[8 * i + 7] = bfhi(w.w); } }
#pragma unroll
        for (int d = 0; d < 64; ++d) o[d] = 0.f;
        float R = 0.f;
        const int tmax = qb * 64 + 63 + NMETA;
        for (int s = tmax - 1; s >= 0; --s) {
            const size_t krow = (size_t)rowof(b, s);
            const u32x4* kp = (const u32x4*)(qkvg + krow * LD1 + 1024 + h * 64); const u32x4* vp = (const u32x4*)(qkvg + krow * LD1 + 2048 + h * 64);
            float z = 0.f;
#pragma unroll
            for (int i = 0; i < 8; ++i) { const u32x4 w = kp[i]; z += q[8 * i] * bflo(w.x) + q[8 * i + 1] * bfhi(w.x) + q[8 * i + 2] * bflo(w.y) + q[8 * i + 3] * bfhi(w.y) + q[8 * i + 4] * bflo(w.z) + q[8 * i + 5] * bfhi(w.z) + q[8 * i + 6] * bflo(w.w) + q[8 * i + 7] * bfhi(w.w); }
            z *= 0.125f;
            const bool valid = s < t;
            const float sp = valid ? softplusf_(z) : 0.f;
            R += sp;
            const float wgt = valid ? __expf(z - R) : 0.f;
#pragma unroll
            for (int i = 0; i < 8; ++i) { const u32x4 w = vp[i]; o[8 * i] += wgt * bflo(w.x); o[8 * i + 1] += wgt * bfhi(w.x); o[8 * i + 2] += wgt * bflo(w.y); o[8 * i + 3] += wgt * bfhi(w.y); o[8 * i + 4] += wgt * bflo(w.z); o[8 * i + 5] += wgt * bfhi(w.z); o[8 * i + 6] += wgt * bflo(w.w); o[8 * i + 7] += wgt * bfhi(w.w); }
        }
        const u32x4* gp = (const u32x4*)(qkvg + row * LD1 + 3072 + h * 64); u32x4* op = (u32x4*)(og + row * 1024 + h * 64);
#pragma unroll
        for (int i = 0; i < 8; ++i) { const u32x4 w = gp[i]; u32x4 r;
            r.x = pk2(o[8 * i] * siluf_(bflo(w.x)), o[8 * i + 1] * siluf_(bfhi(w.x))); r.y = pk2(o[8 * i + 2] * siluf_(bflo(w.y)), o[8 * i + 3] * siluf_(bfhi(w.y)));
            r.z = pk2(o[8 * i + 4] * siluf_(bflo(w.z)), o[8 * i + 5] * siluf_(bfhi(w.z))); r.w = pk2(o[8 * i + 6] * siluf_(bflo(w.w)), o[8 * i + 7] * siluf_(bfhi(w.w)));
            op[i] = r; }
    }
}


typedef float f32x16 __attribute__((ext_vector_type(16)));
typedef short v4i16_t __attribute__((ext_vector_type(4)));
__device__ __forceinline__ f32x4 mfma16(bf16x8 a, bf16x8 b, f32x4 c) { return __builtin_amdgcn_mfma_f32_16x16x32_bf16(a, b, c, 0, 0, 0); }
__device__ __forceinline__ f32x16 mfma32(bf16x8 a, bf16x8 b, f32x16 c) { return __builtin_amdgcn_mfma_f32_32x32x16_bf16(a, b, c, 0, 0, 0); }
__device__ __forceinline__ v4i16_t trd(const LAS unsigned char* p) { return __builtin_amdgcn_ds_read_tr16_b64_v4i16((LAS v4i16_t*)p); }
__device__ __forceinline__ bf16x8 tr8(const LAS unsigned char* p0, const LAS unsigned char* p1) { const v4i16_t lo = trd(p0), hi = trd(p1); return (bf16x8){lo[0], lo[1], lo[2], lo[3], hi[0], hi[1], hi[2], hi[3]}; }
__device__ __forceinline__ bf16x8 ldsb8(const LAS unsigned char* p) { return *(const LAS bf16x8*)p; }

__device__ __forceinline__ void phase_ssd(const Params& p, unsigned char* lds_raw) {
    constexpr int SC = 272, SX = 144;
    constexpr int O_CT = 0, O_BM = 17408, O_SB = 34816, O_X = 52224, O_XW = 61440, O_G = 70656, O_AC = 79872, O_DT = 80128;
    LAS unsigned char* lds = (LAS unsigned char*)lds_raw;
    unsigned char* ws = p.ws;
    bf16_t* proj = (bf16_t*)(ws + OFF_P0); const bf16_t* xc = (const bf16_t*)p.out; float* gsq = (float*)(ws + OFF_STATS) + MTOT;
    const int tid = threadIdx.x, lane = tid & 63, w = __builtin_amdgcn_readfirstlane(tid >> 6), fr = lane & 15, fq = lane >> 4;
    const int lx_ = tid >> 3, cx = tid & 7;
    LAS float* acum_s = (LAS float*)(lds + O_AC); LAS float* dt_s = (LAS float*)(lds + O_DT);
    for (int item = blockIdx.x; item < NB * 16; item += gridDim.x) {
        const int b = item >> 4, h = item & 15, g = h >> 3;
        const float dtb = p.ssd_dt_bias[h], a = -__expf(p.ssd_a_log[h]), dsk = p.ssd_d[h];
        for (int i = tid; i < 17408 / 16; i += NTHREADS) *(LAS u32x4*)(lds + O_SB + 16 * i) = (u32x4){0u, 0u, 0u, 0u};
        f32x4 st[4];
#pragma unroll
        for (int q = 0; q < 4; ++q) st[q] = (f32x4){0.f, 0.f, 0.f, 0.f};
        u32x4 xreg, breg[2], creg[2]; unsigned short dtreg;
#define SSD_ROW(cc, l) ((size_t)((cc) > 0 ? b * SEQ + 64 * ((cc) - 1) + (l) : MREAL + 16 * b + ((l) < 15 ? (l) : 15)))
#define SSD_VALID(cc, l) ((cc) > 0 || (l) < 16)
#define SSD_LOAD(cc) do { \
            xreg = *(const u32x4*)(xc + SSD_ROW(cc, lx_) * XBCW + 64 * h + 8 * cx); \
            _Pragma("unroll") for (int i_ = 0; i_ < 2; ++i_) { const int idx = tid + 512 * i_; const size_t rb = SSD_ROW(cc, idx >> 4); \
                breg[i_] = *(const u32x4*)(xc + rb * XBCW + 1024 + 128 * g + 8 * (idx & 15)); creg[i_] = *(const u32x4*)(xc + rb * XBCW + 1280 + 128 * g + 8 * (idx & 15)); } \
            dtreg = proj[SSD_ROW(cc, lane) * LD0 + C_DT + h]; } while (0)
#define SSD_WRITE(cc) do { \
            float dt_ = SSD_VALID(cc, lane) ? softplusf_(bf2f(dtreg) + dtb) : 0.f; \
            float ac_ = dt_ * a; \
            _Pragma("unroll") for (int o_ = 1; o_ < 64; o_ <<= 1) { const float v_ = __shfl_up(ac_, o_); if (lane >= o_) ac_ += v_; } \
            const float atot_ = __shfl(ac_, 63); const float dtw_ = dt_ * __expf(atot_ - ac_); \
            if (w == 0) { acum_s[lane] = ac_; dt_s[lane] = dt_; } \
            const float mydtw = __shfl(dtw_, lx_ & 63); const bool vx = SSD_VALID(cc, lx_); \
            { u32x4 q_ = xreg; if (!vx) q_ = (u32x4){0u, 0u, 0u, 0u}; *(LAS u32x4*)(lds + O_X + lx_ * SX + 16 * cx) = q_; \
              u32x4 o_; o_.x = pk2(bflo(q_.x) * mydtw, bfhi(q_.x) * mydtw); o_.y = pk2(bflo(q_.y) * mydtw, bfhi(q_.y) * mydtw); o_.z = pk2(bflo(q_.z) * mydtw, bfhi(q_.z) * mydtw); o_.w = pk2(bflo(q_.w) * mydtw, bfhi(q_.w) * mydtw); \
              *(LAS u32x4*)(lds + O_XW + lx_ * SX + 16 * cx) = o_; } \
            _Pragma("unroll") for (int i_ = 0; i_ < 2; ++i_) { const int idx = tid + 512 * i_; const int l_ = idx >> 4; const bool v_ = SSD_VALID(cc, l_); \
                *(LAS u32x4*)(lds + O_BM + l_ * SC + 16 * (idx & 15)) = v_ ? breg[i_] : (u32x4){0u, 0u, 0u, 0u}; \
                *(LAS u32x4*)(lds + O_CT + l_ * SC + 16 * (idx & 15)) = v_ ? creg[i_] : (u32x4){0u, 0u, 0u, 0u}; } } while (0)
        SSD_LOAD(0); SSD_WRITE(0);
        __syncthreads();
        for (int c = 0; c < 33; ++c) {
            if (c + 1 < 33) SSD_LOAD(c + 1);
            const int tl2 = w & 3, l2 = 16 * tl2 + fr; const size_t row2 = SSD_ROW(c, l2); const bool v2 = SSD_VALID(c, l2);
            u32x2 zreg[2];
#pragma unroll
            for (int e = 0; e < 2; ++e) zreg[e] = *(const u32x2*)(proj + row2 * LD0 + C_Z + 64 * h + 16 * (2 * (w >> 2) + e) + 4 * fq);
            {
                const int tl = w >> 1, l = 16 * tl + fr; const float al = acum_s[l];
#pragma unroll
                for (int e = 0; e < 2; ++e) {
                    const int ts = 2 * (w & 1) + e, s0 = 16 * ts + 4 * fq;
                    u32x2 gw = (u32x2){0u, 0u};
                    if (ts <= tl) {
                        f32x4 acc = (f32x4){0.f, 0.f, 0.f, 0.f};
#pragma unroll
                        for (int ks = 0; ks < 4; ++ks) acc = mfma16(ldsb8(lds + O_BM + (16 * ts + fr) * SC + 64 * ks + 16 * fq), ldsb8(lds + O_CT + l * SC + 64 * ks + 16 * fq), acc);
                        const f32x4 as4 = *(const LAS f32x4*)(acum_s + s0), dt4 = *(const LAS f32x4*)(dt_s + s0);
                        float gv[4];
#pragma unroll
                        for (int j = 0; j < 4; ++j) gv[j] = (s0 + j <= l) ? acc[j] * __expf(al - as4[j]) * dt4[j] : 0.f;
                        gw.x = pk2(gv[0], gv[1]); gw.y = pk2(gv[2], gv[3]);
                    }
                    *(LAS u32x2*)(lds + O_G + l * SX + 2 * s0) = gw;
                }
            }
            {
                const float ea = __expf(acum_s[63]); const int tp = w & 3;
#pragma unroll
                for (int q = 0; q < 4; ++q) {
                    const int tn = 4 * (w >> 2) + q;
                    st[q] = st[q] * ea;
#pragma unroll
                    for (int ks = 0; ks < 2; ++ks) {
                        const int r0 = 32 * ks + 8 * fq + (fr >> 2);
                        const bf16x8 af = tr8(lds + O_BM + r0 * SC + 2 * (16 * tn + 4 * (fr & 3)), lds + O_BM + (r0 + 4) * SC + 2 * (16 * tn + 4 * (fr & 3)));
                        const bf16x8 bf = tr8(lds + O_XW + r0 * SX + 2 * (16 * tp + 4 * (fr & 3)), lds + O_XW + (r0 + 4) * SX + 2 * (16 * tp + 4 * (fr & 3)));
                        st[q] = mfma16(af, bf, st[q]);
                    }
                }
            }
            __syncthreads();
            {
                const float eal = __expf(acum_s[l2]); float ss = 0.f;
#pragma unroll
                for (int e = 0; e < 2; ++e) {
                    const int tp = 2 * (w >> 2) + e;
                    f32x4 y1 = (f32x4){0.f, 0.f, 0.f, 0.f}, y2 = (f32x4){0.f, 0.f, 0.f, 0.f};
#pragma unroll
                    for (int ks = 0; ks < 2; ++ks) {
                        const int r0 = 32 * ks + 8 * fq + (fr >> 2);
                        const bf16x8 af = tr8(lds + O_X + r0 * SX + 2 * (16 * tp + 4 * (fr & 3)), lds + O_X + (r0 + 4) * SX + 2 * (16 * tp + 4 * (fr & 3)));
                        y1 = mfma16(af, ldsb8(lds + O_G + l2 * SX + 64 * ks + 16 * fq), y1);
                    }
#pragma unroll
                    for (int ks = 0; ks < 4; ++ks) y2 = mfma16(ldsb8(lds + O_SB + (16 * tp + fr) * SC + 64 * ks + 16 * fq), ldsb8(lds + O_CT + l2 * SC + 64 * ks + 16 * fq), y2);
                    const int p0 = 16 * tp + 4 * fq;
                    const u32x2 xw_ = *(const LAS u32x2*)(lds + O_X + l2 * SX + 2 * p0);
                    const float xv[4] = {bflo(xw_.x), bfhi(xw_.x), bflo(xw_.y), bfhi(xw_.y)};
                    const float zv[4] = {bflo(zreg[e].x), bfhi(zreg[e].x), bflo(zreg[e].y), bfhi(zreg[e].y)};
                    float gv[4];
#pragma unroll
                    for (int j = 0; j < 4; ++j) { gv[j] = (y1[j] + eal * y2[j] + dsk * xv[j]) * siluf_(zv[j]); ss += gv[j] * gv[j]; }
                    if (v2) { u32x2 o_; o_.x = pk2(gv[0], gv[1]); o_.y = pk2(gv[2], gv[3]); *(u32x2*)(proj + row2 * LD0 + C_Z + 64 * h + p0) = o_; }
                }
                ss += __shfl_xor(ss, 16); ss += __shfl_xor(ss, 32);
                if (fq == 0 && v2) atomicAdd(gsq + row2 * 2 + g, ss);
            }
            __syncthreads();
            {
                const int tp = w & 3;
#pragma unroll
                for (int q = 0; q < 4; ++q) { const int tn = 4 * (w >> 2) + q; u32x2 o_; o_.x = pk2(st[q][0], st[q][1]); o_.y = pk2(st[q][2], st[q][3]);
                    *(LAS u32x2*)(lds + O_SB + (16 * tp + fr) * SC + 2 * (16 * tn + 4 * fq)) = o_; }
            }
            if (c + 1 < 33) SSD_WRITE(c + 1);
            __syncthreads();
        }
#undef SSD_ROW
#undef SSD_VALID
#undef SSD_LOAD
#undef SSD_WRITE
    }
}

template <bool MASKED>
__device__ __forceinline__ void sb_block(const f32x16& pz, int kb, int hh, int lim, float& carry, unsigned* pw) {
    constexpr float SCL = 0.125f * 1.4426950408889634f;
    float zl[16], sp[16];
#pragma unroll
    for (int r = 0; r < 16; ++r) {
        zl[r] = pz[r] * SCL;
        const float e = __builtin_amdgcn_exp2f(-fabsf(zl[r]));
        float s_ = fmaxf(zl[r], 0.f) + __builtin_amdgcn_logf(1.f + e);
        if (MASKED) { const int kk = 32 * kb + (r & 3) + 8 * (r >> 2) + 4 * hh; s_ = kk < lim ? s_ : 0.f; }
        sp[r] = s_;
    }
    float gs[4], pg[4];
#pragma unroll
    for (int g = 0; g < 4; ++g) { gs[g] = (sp[4 * g] + sp[4 * g + 1]) + (sp[4 * g + 2] + sp[4 * g + 3]); pg[g] = __shfl_xor(gs[g], 32); }
    float acc = carry, R[16];
#pragma unroll
    for (int g = 3; g >= 0; --g) {
        const float base = acc + (hh == 0 ? pg[g] : 0.f);
        acc += gs[g] + pg[g];
        R[4 * g + 3] = base + sp[4 * g + 3]; R[4 * g + 2] = R[4 * g + 3] + sp[4 * g + 2]; R[4 * g + 1] = R[4 * g + 2] + sp[4 * g + 1]; R[4 * g] = R[4 * g + 1] + sp[4 * g];
    }
    carry = acc;
    float wv[16];
#pragma unroll
    for (int r = 0; r < 16; ++r) {
        wv[r] = __builtin_amdgcn_exp2f(zl[r] - R[r]);
        if (MASKED) { const int kk = 32 * kb + (r & 3) + 8 * (r >> 2) + 4 * hh; wv[r] = kk < lim ? wv[r] : 0.f; }
    }
#pragma unroll
    for (int i = 0; i < 8; ++i) pw[i] = pk2(wv[2 * i], wv[2 * i + 1]);
}

__device__ __forceinline__ void phase_attn(const Params& p, unsigned char* lds_raw) {
    LAS unsigned char* lds = (LAS unsigned char*)lds_raw;
    unsigned char* ws = p.ws;
    const bf16_t* qkvg = (const bf16_t*)(ws + OFF_P0); bf16_t* og = (bf16_t*)(ws + OFF_LA);
    const int tid = threadIdx.x, lane = tid & 63, wid = __builtin_amdgcn_readfirstlane(tid >> 6), r32 = lane & 31, hh = lane >> 5;
    const int kk = tid >> 3, c8 = tid & 7;
    const unsigned koff = (c8 >> 1) * 2048 + (c8 & 1) * 1024 + kk * 16;
    const unsigned voff = (c8 >> 2) * 4096 + kk * 64 + (c8 & 3) * 16;
    constexpr int O_K = 0, O_V = 16384, O_ST = 32768;
    for (int it = blockIdx.x; it < NB * 16 * 8; it += gridDim.x) {
        const int j = 7 - (it >> 9), bh = it & 511, b = bh >> 4, h = bh & 15;
        const int NT = 4 * j + 5;
        const int ubase = 256 * j + 32 * wid, u = ubase + r32;
        const size_t qrow = (size_t)b * SEQ + u;
        bf16x8 qr[4];
#pragma unroll
        for (int ks = 0; ks < 4; ++ks) qr[ks] = *(const bf16x8*)(qkvg + qrow * LD1 + h * 64 + 16 * ks + 8 * hh);
#define KEYROW(ti) ((size_t)((ti) > 0 ? b * SEQ + 64 * ((ti) - 1) + kk : MREAL + 16 * b + (kk < 15 ? kk : 15)))
        u32x4 kreg, vreg;
        { const size_t kr = KEYROW(NT - 1); kreg = *(const u32x4*)(qkvg + kr * LD1 + 1024 + h * 64 + 8 * c8); vreg = *(const u32x4*)(qkvg + kr * LD1 + 2048 + h * 64 + 8 * c8); }
        *(LAS u32x4*)(lds + O_K + koff) = kreg; *(LAS u32x4*)(lds + O_V + voff) = vreg;
        __syncthreads();
        f32x16 o0, o1;
#pragma unroll
        for (int r = 0; r < 16; ++r) { o0[r] = 0.f; o1[r] = 0.f; }
        float carry = 0.f; int cur = 0;
        for (int ti = NT - 1; ti >= 0; --ti) {
            if (ti > 0) { const size_t kr = KEYROW(ti - 1); kreg = *(const u32x4*)(qkvg + kr * LD1 + 1024 + h * 64 + 8 * c8); vreg = *(const u32x4*)(qkvg + kr * LD1 + 2048 + h * 64 + 8 * c8); }
            const int kstart = ti > 0 ? 64 * (ti - 1) : 0;
            const bool skip = ti > 0 && (kstart >= ubase + 31);
            if (!skip) {
                const int lim = ti > 0 ? (u - kstart) : 16;
                const bool full = ti > 0 && (ubase - kstart >= 64);
                f32x16 p0, p1;
#pragma unroll
                for (int r = 0; r < 16; ++r) { p0[r] = 0.f; p1[r] = 0.f; }
                const LAS unsigned char* kb_ = lds + O_K + cur * 8192 + hh * 1024 + r32 * 16;
#pragma unroll
                for (int ks = 0; ks < 4; ++ks) { p0 = mfma32(ldsb8(kb_ + ks * 2048), qr[ks], p0); p1 = mfma32(ldsb8(kb_ + ks * 2048 + 512), qr[ks], p1); }
                unsigned pw[16];
                if (full) { sb_block<false>(p1, 1, hh, lim, carry, pw + 8); sb_block<false>(p0, 0, hh, lim, carry, pw); }
                else { sb_block<true>(p1, 1, hh, lim, carry, pw + 8); sb_block<true>(p0, 0, hh, lim, carry, pw); }
                const LAS unsigned char* vb_ = lds + O_V + cur * 8192 + ((lane >> 4) & 1) * 32 + (lane & 3) * 8 + (4 * hh + ((lane & 15) >> 2)) * 64;
#pragma unroll
                for (int ks = 0; ks < 4; ++ks) {
                    const u32x4 pq = (u32x4){pw[4 * ks], pw[4 * ks + 1], pw[4 * ks + 2], pw[4 * ks + 3]};
                    const bf16x8 pa = __builtin_bit_cast(bf16x8, pq);
                    o0 = mfma32(pa, tr8(vb_ + ks * 1024, vb_ + ks * 1024 + 512), o0);
                    o1 = mfma32(pa, tr8(vb_ + 4096 + ks * 1024, vb_ + 4096 + ks * 1024 + 512), o1);
                }
            }
            if (ti > 0) { *(LAS u32x4*)(lds + O_K + (cur ^ 1) * 8192 + koff) = kreg; *(LAS u32x4*)(lds + O_V + (cur ^ 1) * 8192 + voff) = vreg; }
            __syncthreads();
            cur ^= 1;
        }
#undef KEYROW
        LAS float* stg = (LAS float*)(lds + O_ST + wid * 8192);
#pragma unroll
        for (int r = 0; r < 16; ++r) { const int orow = (r & 3) + 8 * (r >> 2) + 4 * hh; stg[orow * 64 + r32] = o0[r]; stg[orow * 64 + 32 + r32] = o1[r]; }
        const size_t qrow0 = (size_t)b * SEQ + ubase;
#pragma unroll
        for (int i = 0; i < 4; ++i) {
            const int row = i * 8 + (lane >> 3), ch = lane & 7;
            const f32x4 a0 = *(const LAS f32x4*)(stg + row * 64 + 8 * ch), a1 = *(const LAS f32x4*)(stg + row * 64 + 8 * ch + 4);
            const u32x4 gq = *(const u32x4*)(qkvg + (qrow0 + row) * LD1 + 3072 + h * 64 + 8 * ch);
            u32x4 o_;
            o_.x = pk2(a0[0] * siluf_(bflo(gq.x)), a0[1] * siluf_(bfhi(gq.x))); o_.y = pk2(a0[2] * siluf_(bflo(gq.y)), a0[3] * siluf_(bfhi(gq.y)));
            o_.z = pk2(a1[0] * siluf_(bflo(gq.z)), a1[1] * siluf_(bfhi(gq.z))); o_.w = pk2(a1[2] * siluf_(bflo(gq.w)), a1[3] * siluf_(bfhi(gq.w)));
            *(u32x4*)(og + (qrow0 + row) * 1024 + h * 64 + 8 * ch) = o_;
        }
    }
}

__device__ __forceinline__ void phase_final(const Params& p) {
    const float* rsq2 = (const float*)(p.ws + OFF_STATS) + 4 * MTOT;
    const long total = (long)MREAL * 256;
    for (long it = (long)blockIdx.x * NTHREADS + threadIdx.x; it < total; it += (long)gridDim.x * NTHREADS) {
        const int c = (int)(it & 255); const size_t row = (size_t)(it >> 8);
        const float s = rsqrtf(rsq2[row] * (1.f / 1024.f) + EPS);
        f32x4* ptr = (f32x4*)(p.out + row * 1024 + 4 * c);
        const f32x4 w = *(const f32x4*)(p.final_norm + 4 * c);
        f32x4 v = *ptr; v = v * s * w; *ptr = v;
    }
}

constexpr int LDS_BYTES = 147456;
__global__ void __launch_bounds__(NTHREADS) fwd_kernel(Params p) {
    extern __shared__ __attribute__((aligned(16))) unsigned char lds_raw[];
    LAS unsigned char* lds = (LAS unsigned char*)lds_raw;
    unsigned char* ws = p.ws;
    const int lo = p.ph_lo, hi = p.ph_hi;
    float* stats = (float*)(ws + OFF_STATS);
#ifndef PHMASK
#define PHMASK 0x3ff
#endif
#define IN(k) (((PHMASK >> (k)) & 1) && lo <= (k) && (k) < hi)
#define SEAM(k) do { if (IN(k) && IN((k) + 1)) { cg::this_grid().sync(); } } while (0)
    if (IN(0)) { phase0(p, lds_raw); }
    SEAM(0);
    if (IN(1)) {
        pg8::Gemm g{(const bf16_t*)(ws + OFF_XB), (const bf16_t*)(ws + OFF_W0T), 1024, 1024, 1024, 0};
        pg8::StaticOrder S; S.init(258, 19, gridDim.x, blockIdx.x);
        pg8::EpiScaleBf16 E{(bf16_t*)(ws + OFF_P0), LD0, stats, EVEN_IN};
        pg8::gemm_phase(lds, g, S, E);
    }
    SEAM(1);
    if (IN(2)) { phase_conv(p); }
    SEAM(2);
    if (IN(3)) {
        pg8::Gemm g{(const bf16_t*)(ws + OFF_XB), (const bf16_t*)(ws + OFF_WGT), 1024, 256, 256, 256};
        pg8::StaticOrder S; S.init(258, 8, gridDim.x, blockIdx.x);
        pg8::EpiGates E{(const bf16_t*)(ws + OFF_XB), p.lru_b_a, p.lru_b_x, stats + 5 * MTOT, (bf16_t*)(ws + OFF_LA), (bf16_t*)(ws + OFF_BB)};
        pg8::gemm_phase(lds, g, S, E);
#if SSD_NAIVE
        phase_ssd_naive(p);
#else
        phase_ssd(p, lds_raw);
#endif
    }
    SEAM(3);
    if (IN(4)) { phase_scan(p, lds_raw); }
    SEAM(4);
    if (IN(5)) {
        pg8::Gemm g{(const bf16_t*)(ws + OFF_P0) + C_LRUG, (const bf16_t*)(ws + OFF_WO0T), LD0, 2048, 2048, 0};
        pg8::StaticOrder S; S.init(258, 4, gridDim.x, blockIdx.x);
        pg8::EpiOut0 E{p.x, p.meta, (bf16_t*)(ws + OFF_XB), stats + 3 * MTOT};
        pg8::gemm_phase(lds, g, S, E);
    }
    SEAM(5);
    if (IN(6)) {
        pg8::Gemm g{(const bf16_t*)(ws + OFF_XB), (const bf16_t*)(ws + OFF_W1T), 1024, 1024, 1024, 0};
        pg8::StaticOrder S; S.init(258, 16, gridDim.x, blockIdx.x);
        pg8::EpiScaleBf16 E{(bf16_t*)(ws + OFF_P0), LD1, stats + 3 * MTOT, LD1};
        pg8::gemm_phase(lds, g, S, E);
    }
    SEAM(6);
#if ATTN_NAIVE
    if (IN(7)) { phase_attn_naive(p); }
#else
    if (IN(7)) { phase_attn(p, lds_raw); }
#endif
    SEAM(7);
    if (IN(8)) {
        pg8::Gemm g{(const bf16_t*)(ws + OFF_LA), (const bf16_t*)(ws + OFF_WO1T), 1024, 1024, 1024, 0};
        pg8::StaticOrder S; S.init(256, 4, gridDim.x, blockIdx.x);
        pg8::EpiOut1 E{(const bf16_t*)(ws + OFF_XB), p.out, stats + 4 * MTOT};
        pg8::gemm_phase(lds, g, S, E);
    }
    SEAM(8);
    if (IN(9)) { phase_final(p); }
#undef IN
#undef SEAM
}

extern "C" void kernel_launch(void* const* d_in, const int* in_sizes, int n_in, void* d_out, int out_size, void* d_ws, size_t ws_size, hipStream_t stream) {
    static int grid = 0;
    if (grid == 0) {
        if (n_in != 22 || ws_size < WS_END) { fprintf(stderr, "kernel_launch: unexpected inputs (n_in %d, ws %zu < %zu)\n", n_in, ws_size, (size_t)WS_END); grid = -1; return; }
        int dev = 0, cus = 0, per_cu = 0;
        hipGetDevice(&dev); hipDeviceGetAttribute(&cus, hipDeviceAttributeMultiprocessorCount, dev);
        hipFuncSetAttribute((const void*)fwd_kernel, hipFuncAttributeMaxDynamicSharedMemorySize, LDS_BYTES);
        hipOccupancyMaxActiveBlocksPerMultiprocessor(&per_cu, (const void*)fwd_kernel, NTHREADS, LDS_BYTES);
        (void)hipGetLastError();
        if (per_cu < 1) per_cu = 1;
        grid = cus * 1;
    }
    if (grid < 0) return;
    Params p{};
    const float** pp = (const float**)&p;
    for (int i = 0; i < 22; ++i) pp[i] = (const float*)d_in[i];
    p.out = (float*)d_out; p.ws = (unsigned char*)d_ws;
#if N_LAUNCH_MODE == 1
    p.ph_lo = 0; p.ph_hi = 10;
    void* args[] = {&p};
    hipError_t e = hipLaunchCooperativeKernel((const void*)fwd_kernel, dim3(grid), dim3(NTHREADS), args, LDS_BYTES, stream);
    if (e != hipSuccess) fprintf(stderr, "cooperative launch failed: %s (grid %d)\n", hipGetErrorString(e), grid);
#else
    for (int ph = 0; ph < 10; ++ph) {
        p.ph_lo = ph; p.ph_hi = ph + 1;
        hipLaunchKernelGGL(fwd_kernel, dim3(grid), dim3(NTHREADS), LDS_BYTES, stream, p);
    }
#endif
}
```

```cpp
#include <hip/hip_runtime.h>
#include <hip/hip_cooperative_groups.h>
#include <cstdint>
#include <cstdio>
namespace cg = cooperative_groups;

#ifndef N_LAUNCH_MODE
#define N_LAUNCH_MODE 1
#endif
#ifndef SSD_NAIVE
#define SSD_NAIVE 0
#endif
#ifndef SB_EARLY_EXIT
#define SB_EARLY_EXIT 1
#endif
#ifndef ATTN_NAIVE
#define ATTN_NAIVE 0
#endif

#define LAS __attribute__((address_space(3)))
typedef unsigned short bf16_t;
typedef short bf16x8 __attribute__((ext_vector_type(8)));
typedef float f32x4 __attribute__((ext_vector_type(4)));
typedef float f32x2 __attribute__((ext_vector_type(2)));
typedef unsigned u32x4 __attribute__((ext_vector_type(4)));
typedef unsigned u32x2 __attribute__((ext_vector_type(2)));
typedef __bf16 bf16x2_t __attribute__((ext_vector_type(2)));

constexpr int NB = 32, SEQ = 2048, NMETA = 16, LL = SEQ + NMETA, DM = 1024;
constexpr int MREAL = NB * SEQ;
constexpr int MTOT = MREAL + NB * NMETA;
constexpr int EVEN_IN = 4624, N0PAD = 4864, LD0 = 4624;
constexpr int C_LRUX = 0, C_LRUG = 1024, C_Z = 2048, C_XBC = 3072, C_DT = 4608;
constexpr int XBCW = 1536;
constexpr int LD1 = 4096;
constexpr float EPS = 1e-6f;
constexpr int NTHREADS = 512;

constexpr size_t MiB = 1u << 20;
constexpr size_t OFF_W0T = 0;
constexpr size_t OFF_WGT = 10 * MiB;
constexpr size_t OFF_WO0T = 11 * MiB;
constexpr size_t OFF_W1T = 15 * MiB;
constexpr size_t OFF_WO1T = 23 * MiB;
constexpr size_t OFF_STATS = 25 * MiB;
constexpr size_t OFF_BAR = 26 * MiB + 512 * 1024;
constexpr size_t OFF_XB = 27 * MiB;
constexpr size_t SZ_ACT = (size_t)MTOT * 1024 * 2;
constexpr size_t OFF_P0 = OFF_XB + SZ_ACT;
constexpr size_t SZ_P0 = (size_t)MTOT * LD0 * 2;
constexpr size_t OFF_LA = OFF_P0 + SZ_P0;
constexpr size_t OFF_BB = OFF_LA + SZ_ACT;
constexpr size_t WS_END = OFF_BB + SZ_ACT;
static_assert(WS_END <= (size_t)1024 * MiB, "workspace map");

struct Params {
    const float* x; const float* meta; const float* even_norm; const float* even_w_in;
    const float* lru_conv_w; const float* lru_conv_b; const float* lru_w_a; const float* lru_b_a;
    const float* lru_w_x; const float* lru_b_x; const float* lru_lambda; const float* ssd_conv_w;
    const float* ssd_conv_b; const float* ssd_dt_bias; const float* ssd_a_log; const float* ssd_d;
    const float* ssd_norm; const float* even_w_out; const float* odd_norm; const float* odd_w_in;
    const float* odd_w_out; const float* final_norm;
    float* out; unsigned char* ws;
    int ph_lo, ph_hi;
};

__device__ __forceinline__ unsigned pk2(float lo, float hi) { f32x2 v = {lo, hi}; bf16x2_t b = __builtin_convertvector(v, bf16x2_t); return __builtin_bit_cast(unsigned, b); }
__device__ __forceinline__ float bflo(unsigned w) { return __uint_as_float(w << 16); }
__device__ __forceinline__ float bfhi(unsigned w) { return __uint_as_float(w & 0xffff0000u); }
__device__ __forceinline__ float bf2f(bf16_t h) { return __uint_as_float((unsigned)h << 16); }
__device__ __forceinline__ bf16_t f2bf(float f) { return (bf16_t)(pk2(f, 0.f) & 0xffffu); }
__device__ __forceinline__ int rowof(int b, int t) { return t >= NMETA ? b * SEQ + (t - NMETA) : MREAL + b * NMETA + t; }
__device__ __forceinline__ float sigmoidf_(float v) { return 1.f / (1.f + __expf(-v)); }
__device__ __forceinline__ float siluf_(float v) { return v / (1.f + __expf(-v)); }
__device__ __forceinline__ float softplusf_(float v) { return fmaxf(v, 0.f) + log1pf(__expf(-fabsf(v))); }
__device__ __forceinline__ float wave_sum(float v) {
#pragma unroll
    for (int o = 1; o < 64; o <<= 1) v += __shfl_xor(v, o);
    return v;
}

namespace pg8 {
constexpr int BM = 256, BK = 64, HALF = 128, HTB = HALF * BK * 2, STAGE_BYTES = 8 * HTB, NXCD = 8, WGM = 8;
__host__ __device__ __forceinline__ int lds_byte(int r, int c) { const int st = (r >> 4) * 2 + (c >> 5), rr = r & 15, cc = c & 31, ob = rr * 64 + cc * 2; return st * 1024 + (ob ^ (((ob >> 9) & 1) << 5)); }
__host__ __device__ __forceinline__ void stage_rc(int b, int& R, int& C) { const int st = b / 1024, sb = b % 1024, swz = sb ^ (((sb >> 9) & 1) << 5); R = (st >> 1) * 16 + swz / 64; C = (st & 1) * 32 + (swz % 64) / 2; }
__host__ __device__ __forceinline__ int perm32(int rho) { const int n = rho >> 4, i = rho & 15; return 8 * (i >> 2) + 4 * n + (i & 3); }

struct Unit { int pm, pn; };
struct Gemm { const bf16_t* A; const bf16_t* Bt; int lda, ldb, K, agrp; };
struct StaticOrder {
    int nM, nN, nwg, G, c;
    __device__ void init(int nM_, int nN_, int G_, int c_) { nM = nM_; nN = nN_; nwg = nM * nN; G = G_; c = c_; }
    __device__ bool next(int i, Unit& u) const {
        const long L = (long)i * G + c; if (L >= nwg) return false;
        int wgid = (int)L; { const int q = nwg / NXCD, r = nwg % NXCD, xcd = wgid % NXCD, off = wgid / NXCD; wgid = (xcd < r ? xcd * (q + 1) : r * (q + 1) + (xcd - r) * q) + off; }
        const int nig = WGM * nN, gid = wgid / nig, fm = gid * WGM, gsz = (nM - fm) < WGM ? (nM - fm) : WGM;
        u.pm = fm + ((wgid % nig) % gsz); u.pn = (wgid % nig) / gsz; return true;
    }
};

struct EpiScaleBf16 {
    static constexpr bool PERM = true;
    bf16_t* O; int ldc; const float* rsq; int ncols;
    __device__ __forceinline__ void operator()(const f32x4 (&acc)[2][2][4][2], const Unit& u, int wr, int wc, int fr, int fq) const {
        const int row0 = u.pm * BM + wr * 64 + fr, col0 = u.pn * BM + wc * 32 + 8 * fq;
#pragma unroll
        for (int ai = 0; ai < 2; ++ai)
#pragma unroll
            for (int m = 0; m < 4; ++m) {
                const int row = row0 + ai * HALF + m * 16;
                const float s = rsqrtf(rsq[row] * (1.f / 1024.f) + EPS);
                bf16_t* rowp = O + (size_t)row * ldc + col0;
#pragma unroll
                for (int bj = 0; bj < 2; ++bj) {
                    if (col0 + bj * HALF < ncols) {
                        const f32x4 v0 = acc[ai][bj][m][0] * s, v1 = acc[ai][bj][m][1] * s;
                        u32x4 w; w.x = pk2(v0[0], v0[1]); w.y = pk2(v0[2], v0[3]); w.z = pk2(v1[0], v1[1]); w.w = pk2(v1[2], v1[3]);
                        *(u32x4*)(rowp + bj * HALF) = w;
                    }
                }
            }
    }
};
struct EpiGates {
    static constexpr bool PERM = false;
    const bf16_t* lx; const float* b_a; const float* b_x; const float* lam; bf16_t* la; bf16_t* bb;
    __device__ __forceinline__ void operator()(const f32x4 (&acc)[2][2][4][2], const Unit& u, int wr, int wc, int fr, int fq) const {
        const int row0 = u.pm * BM + wr * 64 + fr;
        const int ch0 = (u.pn >> 1) * 256 + (u.pn & 1) * 128 + wc * 32 + 4 * fq;
#pragma unroll
        for (int ai = 0; ai < 2; ++ai)
#pragma unroll
            for (int m = 0; m < 4; ++m) {
                const int row = row0 + ai * HALF + m * 16;
#pragma unroll
                for (int n = 0; n < 2; ++n) {
                    const int ch = ch0 + 16 * n;
                    const f32x4 ba = *(const f32x4*)(b_a + ch), bx = *(const f32x4*)(b_x + ch), cneg = *(const f32x4*)(lam + ch);
                    const u32x2 lw = *(const u32x2*)(lx + (size_t)row * 1024 + ch);
                    const float lxv[4] = {bflo(lw.x), bfhi(lw.x), bflo(lw.y), bfhi(lw.y)};
                    float lo[4], bo[4];
#pragma unroll
                    for (int j = 0; j < 4; ++j) {
                        const float r = sigmoidf_(acc[ai][0][m][n][j] + ba[j]);
                        const float ig = sigmoidf_(acc[ai][1][m][n][j] + bx[j]);
                        const float loga = cneg[j] * r;
                        const float a2 = __expf(2.f * loga);
                        lo[j] = loga; bo[j] = sqrtf(fmaxf(1.f - a2, 0.f)) * ig * lxv[j];
                    }
                    u32x2 w0; w0.x = pk2(lo[0], lo[1]); w0.y = pk2(lo[2], lo[3]);
                    u32x2 w1; w1.x = pk2(bo[0], bo[1]); w1.y = pk2(bo[2], bo[3]);
                    *(u32x2*)(la + (size_t)row * 1024 + ch) = w0;
                    *(u32x2*)(bb + (size_t)row * 1024 + ch) = w1;
                    asm volatile("" ::: "memory");
                }
            }
    }
};
struct EpiOut0 {
    static constexpr bool PERM = false;
    const float* x; const float* meta; bf16_t* h1b; float* rsq;
    __device__ __forceinline__ void operator()(const f32x4 (&acc)[2][2][4][2], const Unit& u, int wr, int wc, int fr, int fq) const {
        const int row0 = u.pm * BM + wr * 64 + fr, col0 = u.pn * BM + wc * 32 + 4 * fq;
#pragma unroll
        for (int ai = 0; ai < 2; ++ai)
#pragma unroll
            for (int m = 0; m < 4; ++m) {
                const int row = row0 + ai * HALF + m * 16;
                const float* src = row < MREAL ? x + (size_t)row * 1024 : meta + (size_t)((row - MREAL) & 15) * 1024;
                float ss = 0.f;
#pragma unroll
                for (int bj = 0; bj < 2; ++bj)
#pragma unroll
                    for (int n = 0; n < 2; ++n) {
                        const int col = col0 + bj * HALF + n * 16;
                        const f32x4 v = acc[ai][bj][m][n] + *(const f32x4*)(src + col);
                        ss += (v[0] * v[0] + v[1] * v[1]) + (v[2] * v[2] + v[3] * v[3]);
                        u32x2 w; w.x = pk2(v[0], v[1]); w.y = pk2(v[2], v[3]);
                        *(u32x2*)(h1b + (size_t)row * 1024 + col) = w;
                    }
                ss += __shfl_xor(ss, 16); ss += __shfl_xor(ss, 32);
                if (fq == 0) atomicAdd(rsq + row, ss);
            }
    }
};
struct EpiOut1 {
    static constexpr bool PERM = false;
    const bf16_t* h1b; float* out; float* rsq;
    __device__ __forceinline__ void operator()(const f32x4 (&acc)[2][2][4][2], const Unit& u, int wr, int wc, int fr, int fq) const {
        const int row0 = u.pm * BM + wr * 64 + fr, col0 = u.pn * BM + wc * 32 + 4 * fq;
#pragma unroll
        for (int ai = 0; ai < 2; ++ai)
#pragma unroll
            for (int m = 0; m < 4; ++m) {
                const int row = row0 + ai * HALF + m * 16;
                float ss = 0.f;
#pragma unroll
                for (int bj = 0; bj < 2; ++bj)
#pragma unroll
                    for (int n = 0; n < 2; ++n) {
                        const int col = col0 + bj * HALF + n * 16;
                        const u32x2 hw = *(const u32x2*)(h1b + (size_t)row * 1024 + col);
                        f32x4 v = acc[ai][bj][m][n];
                        v[0] += bflo(hw.x); v[1] += bfhi(hw.x); v[2] += bflo(hw.y); v[3] += bfhi(hw.y);
                        ss += (v[0] * v[0] + v[1] * v[1]) + (v[2] * v[2] + v[3] * v[3]);
                        *(f32x4*)(out + (size_t)row * 1024 + col) = v;
                    }
                ss += __shfl_xor(ss, 16); ss += __shfl_xor(ss, 32);
                if (fq == 0) atomicAdd(rsq + row, ss);
            }
    }
};

template <class Epi, class Sched>
__device__ __forceinline__ void gemm_phase(LAS unsigned char* lds, const Gemm g, const Sched& S, const Epi& E) {
    const int tid = threadIdx.x, wid = __builtin_amdgcn_readfirstlane(tid >> 6), lane = tid & 63, wr = wid >> 2, wc = wid & 3, fr = lane & 15, fq = lane >> 4;
    const int K = g.K, nt = K / BK;
    unsigned voffA[2], voffB[2];
#pragma unroll
    for (int i = 0; i < 2; ++i) { int R, C; stage_rc(tid * 16 + i * 8192, R, C); const int Rb = Epi::PERM ? ((R & ~31) + perm32(R & 31)) : R;
        voffA[i] = (unsigned)(R * g.lda + C) * 2u; voffB[i] = (unsigned)(Rb * g.ldb + C) * 2u; }
    const size_t kstep = (size_t)(BK * 2);
    const size_t hstepA = (size_t)HALF * g.lda * 2, hstepB = (size_t)HALF * g.ldb * 2;
    const size_t tstepA = 2 * hstepA, tstepB = 2 * hstepB;
    const unsigned ldsw = (unsigned)wid * 1024u;
    const int aoff = lds_byte(wr * 64 + fr, fq * 8), boff = lds_byte(wc * 32 + fr, fq * 8);
#define PG8_SA(b, h) (((b) * 2 + (h)) * HTB)
#define PG8_SB(b, h) ((4 + (b) * 2 + (h)) * HTB)
#define PG8_STAGE(bufoff, gbase, voff) do { _Pragma("unroll") for (int _i = 0; _i < 2; ++_i) \
        __builtin_amdgcn_global_load_lds((const unsigned*)((const char*)(gbase) + (voff)[_i]), (LAS unsigned*)(lds + (bufoff) + ldsw + _i * 8192), 16, 0, 0); } while (0)
#define PG8_LDA(dst, b, h) do { _Pragma("unroll") for (int m = 0; m < 4; ++m) _Pragma("unroll") for (int k = 0; k < 2; ++k) dst[m][k] = *(const LAS bf16x8*)(lds + PG8_SA(b, h) + aoff + m * 2048 + k * 1024); } while (0)
#define PG8_LDB(dst, b, h) do { _Pragma("unroll") for (int n = 0; n < 2; ++n) _Pragma("unroll") for (int k = 0; k < 2; ++k) dst[n][k] = *(const LAS bf16x8*)(lds + PG8_SB(b, h) + boff + n * 2048 + k * 1024); } while (0)
#define PG8_MMA(ai, bj, At, Bt) do { __builtin_amdgcn_s_setprio(1); _Pragma("unroll") for (int m = 0; m < 4; ++m) _Pragma("unroll") for (int n = 0; n < 2; ++n) _Pragma("unroll") for (int k = 0; k < 2; ++k) \
        acc[ai][bj][m][n] = __builtin_amdgcn_mfma_f32_16x16x32_bf16(Bt[n][k], At[m][k], acc[ai][bj][m][n], 0, 0, 0); __builtin_amdgcn_s_setprio(0); } while (0)
#define PG8_WAIT_V(n) asm volatile("s_waitcnt vmcnt(" #n ")" ::: "memory")
#define PG8_WAIT_L(n) asm volatile("s_waitcnt lgkmcnt(" #n ")" ::: "memory")
#define PG8_BAR __builtin_amdgcn_s_barrier()
#define PG8_SCHED __builtin_amdgcn_sched_barrier(0)
    Unit cur, nxt; int ui = 0;
    if (!S.next(0, cur)) return;
    f32x4 acc[2][2][4][2];
#pragma unroll
    for (int a = 0; a < 2; ++a)
#pragma unroll
        for (int b = 0; b < 2; ++b)
#pragma unroll
            for (int m = 0; m < 4; ++m)
#pragma unroll
                for (int n = 0; n < 2; ++n) acc[a][b][m][n] = (f32x4){0.f, 0.f, 0.f, 0.f};
    bf16x8 At[4][2], B0[2][2], B1[2][2];
    const char* cA = (const char*)g.A + (size_t)cur.pm * tstepA + (size_t)((cur.pn >> 1) * g.agrp) * 2; const char* cB = (const char*)g.Bt + (size_t)cur.pn * tstepB;
    PG8_STAGE(PG8_SB(0, 0), cB, voffB); PG8_STAGE(PG8_SB(0, 1), cB + hstepB, voffB); PG8_STAGE(PG8_SA(0, 0), cA, voffA); PG8_STAGE(PG8_SA(0, 1), cA + hstepA, voffA);
    if (wr == 1) PG8_BAR;
    PG8_WAIT_V(2); PG8_BAR;
    PG8_STAGE(PG8_SB(1, 0), cB + kstep, voffB); PG8_STAGE(PG8_SA(1, 0), cA + kstep, voffA); PG8_STAGE(PG8_SB(1, 1), cB + hstepB + kstep, voffB);
    PG8_WAIT_V(6); PG8_BAR;
    for (;;) {
        const bool has_next = S.next(ui + 1, nxt);
        const char* nA = has_next ? (const char*)g.A + (size_t)nxt.pm * tstepA + (size_t)((nxt.pn >> 1) * g.agrp) * 2 : cA; const char* nB = has_next ? (const char*)g.Bt + (size_t)nxt.pn * tstepB : cB;
        for (int t = 0; t < nt; t += 2) {
            const bool last = (t == nt - 2);
            const char* a1 = cA + (size_t)(t + 1) * kstep;
            const char* a2 = last ? nA : cA + (size_t)(t + 2) * kstep; const char* b2 = last ? nB : cB + (size_t)(t + 2) * kstep;
            const char* a3 = a2 + kstep; const char* b3 = b2 + kstep;
            PG8_LDB(B0, 0, 0); PG8_LDB(B1, 0, 1); PG8_SCHED; PG8_LDA(At, 0, 0); PG8_STAGE(PG8_SA(1, 1), a1 + hstepA, voffA);
            PG8_WAIT_V(8); PG8_WAIT_L(0); PG8_BAR; PG8_MMA(0, 0, At, B0); PG8_MMA(0, 1, At, B1); PG8_BAR; PG8_SCHED;
            PG8_LDA(At, 0, 1); PG8_STAGE(PG8_SB(0, 0), b2, voffB); PG8_STAGE(PG8_SB(0, 1), b2 + hstepB, voffB); PG8_STAGE(PG8_SA(0, 0), a2, voffA);
            PG8_WAIT_V(8); PG8_WAIT_L(0); PG8_BAR; PG8_MMA(1, 0, At, B0); PG8_MMA(1, 1, At, B1); PG8_BAR; PG8_SCHED;
            PG8_LDB(B0, 1, 0); PG8_LDB(B1, 1, 1); PG8_SCHED; PG8_LDA(At, 1, 0); PG8_STAGE(PG8_SA(0, 1), a2 + hstepA, voffA);
            PG8_WAIT_V(8); PG8_WAIT_L(0); PG8_BAR; PG8_MMA(0, 0, At, B0); PG8_MMA(0, 1, At, B1); PG8_BAR; PG8_SCHED;
            PG8_LDA(At, 1, 1); PG8_STAGE(PG8_SB(1, 0), b3, voffB); PG8_STAGE(PG8_SB(1, 1), b3 + hstepB, voffB); PG8_STAGE(PG8_SA(1, 0), a3, voffA);
            PG8_WAIT_V(8); PG8_WAIT_L(0); PG8_BAR; PG8_MMA(1, 0, At, B0); PG8_MMA(1, 1, At, B1); PG8_BAR; PG8_SCHED;
        }
        if (wr == 0) PG8_BAR;
        E(acc, cur, wr, wc, fr, fq);
        if (!has_next) break;
#pragma unroll
        for (int a = 0; a < 2; ++a)
#pragma unroll
            for (int b = 0; b < 2; ++b)
#pragma unroll
                for (int m = 0; m < 4; ++m)
#pragma unroll
                    for (int n = 0; n < 2; ++n) acc[a][b][m][n] = (f32x4){0.f, 0.f, 0.f, 0.f};
        cur = nxt; cA = nA; cB = nB; ++ui;
        if (wr == 1) PG8_BAR;
    }
    PG8_WAIT_V(0);
    PG8_BAR;
#undef PG8_SA
#undef PG8_SB
#undef PG8_STAGE
#undef PG8_LDA
#undef PG8_LDB
#undef PG8_MMA
#undef PG8_WAIT_V
#undef PG8_WAIT_L
#undef PG8_BAR
#undef PG8_SCHED
}
}

__device__ __forceinline__ void transpose_tile(const float* src, int src_ld, int n_valid, int k0, int n0, bf16_t* dst, int dst_ld, int dst_row0, const float* kscale, float* scr, int lane) {
#pragma unroll 8
    for (int i = 0; i < 32; ++i) {
        const int kk = 2 * i + (lane >> 5), n = n0 + (lane & 31);
        float v = n < n_valid ? src[(size_t)(k0 + kk) * src_ld + n] : 0.f;
        if (kscale) v *= kscale[k0 + kk];
        scr[kk * 33 + (lane & 31)] = v;
    }
    asm volatile("s_waitcnt lgkmcnt(0)" ::: "memory");
    const int c = lane & 7;
#pragma unroll
    for (int j = 0; j < 4; ++j) {
        const int n = (lane >> 3) + 8 * j; const float* s = scr + (8 * c) * 33 + n;
        u32x4 o; o.x = pk2(s[0 * 33], s[1 * 33]); o.y = pk2(s[2 * 33], s[3 * 33]); o.z = pk2(s[4 * 33], s[5 * 33]); o.w = pk2(s[6 * 33], s[7 * 33]);
        *(u32x4*)(dst + (size_t)(dst_row0 + n) * dst_ld + k0 + 8 * c) = o;
    }
    asm volatile("s_waitcnt lgkmcnt(0)" ::: "memory");
}

__device__ __forceinline__ void phase0(const Params& p, unsigned char* lds) {
    unsigned char* ws = p.ws;
    const int tid = threadIdx.x, lane = tid & 63, wave = tid >> 6;
    const int gw = blockIdx.x * 8 + wave, NGW = gridDim.x * 8;
    float* scr = (float*)(lds + wave * 16384);
    bf16_t* W0T = (bf16_t*)(ws + OFF_W0T); bf16_t* WGT = (bf16_t*)(ws + OFF_WGT); bf16_t* WO0T = (bf16_t*)(ws + OFF_WO0T);
    bf16_t* W1T = (bf16_t*)(ws + OFF_W1T); bf16_t* WO1T = (bf16_t*)(ws + OFF_WO1T);
    constexpr int I_W0 = 16 * 152, I_G = 256, I_O0 = 32 * 32, I_W1 = 16 * 128, I_O1 = 16 * 32;
    constexpr int NIT = I_W0 + I_G + I_O0 + I_W1 + I_O1;
    for (int it = gw; it < NIT; it += NGW) {
        int r = it;
        if (r < I_W0) { const int kb = r / 152, nb = r % 152; transpose_tile(p.even_w_in, EVEN_IN, EVEN_IN, 64 * kb, 32 * nb, W0T, 1024, 32 * nb, p.even_norm, scr, lane); continue; }
        r -= I_W0;
        if (r < I_G) {
            const int nb = r & 3, kb = (r >> 2) & 3, tp = (r >> 4) & 1, which = (r >> 5) & 1, g = r >> 6;
            const float* src = (which ? p.lru_w_x : p.lru_w_a) + (size_t)g * 65536;
            transpose_tile(src, 256, 256, 64 * kb, 128 * tp + 32 * nb, WGT, 256, (2 * g + tp) * 256 + which * 128 + 32 * nb, nullptr, scr, lane); continue; }
        r -= I_G;
        if (r < I_O0) { const int kb = r / 32, nb = r % 32;
            transpose_tile(p.even_w_out, 1024, 1024, 64 * kb, 32 * nb, WO0T, 2048, 32 * nb, kb >= 16 ? p.ssd_norm - 1024 : nullptr, scr, lane); continue; }
        r -= I_O0;
        if (r < I_W1) { const int kb = r / 128, nb = r % 128; transpose_tile(p.odd_w_in, 4096, 4096, 64 * kb, 32 * nb, W1T, 1024, 32 * nb, p.odd_norm, scr, lane); continue; }
        r -= I_W1;
        { const int kb = r / 32, nb = r % 32; transpose_tile(p.odd_w_out, 1024, 1024, 64 * kb, 32 * nb, WO1T, 1024, 32 * nb, nullptr, scr, lane); }
    }
    bf16_t* xb = (bf16_t*)(ws + OFF_XB); float* stats = (float*)(ws + OFF_STATS);
    for (int m = gw; m < MTOT; m += NGW) {
        const float* src = m < MREAL ? p.x + (size_t)m * 1024 : p.meta + (size_t)((m - MREAL) & 15) * 1024;
        const f32x4* xr = (const f32x4*)src + lane; float s = 0.f;
        unsigned long long* o8 = (unsigned long long*)(xb + (size_t)m * 1024) + lane;
#pragma unroll
        for (int j = 0; j < 4; ++j) { const f32x4 v = xr[64 * j]; s += (v[0] * v[0] + v[1] * v[1]) + (v[2] * v[2] + v[3] * v[3]);
            o8[64 * j] = (unsigned long long)pk2(v[0], v[1]) | ((unsigned long long)pk2(v[2], v[3]) << 32); }
        s = wave_sum(s);
        if (lane == 0) stats[m] = s;
    }
    if (blockIdx.x == 0) for (int i = tid; i < 1024; i += NTHREADS) stats[5 * MTOT + i] = -8.f * log1pf(__expf(-p.lru_lambda[i]));
    for (int i = blockIdx.x * NTHREADS + tid; i < 4 * MTOT; i += gridDim.x * NTHREADS) stats[MTOT + i] = 0.f;
}

__device__ __forceinline__ void phase_conv(const Params& p) {
    unsigned char* ws = p.ws;
    const bf16_t* proj = (const bf16_t*)(ws + OFF_P0);
    bf16_t* lx = (bf16_t*)(ws + OFF_XB); bf16_t* xc = (bf16_t*)p.out;
    constexpr int NCH = 320, NTB = LL / 16;
    const long total = (long)NB * NTB * NCH;
    for (long it = (long)blockIdx.x * NTHREADS + threadIdx.x; it < total; it += (long)gridDim.x * NTHREADS) {
        const int c = (int)(it % NCH); const int tb = (int)((it / NCH) % NTB); const int b = (int)(it / ((long)NCH * NTB));
        const bool is_lru = c < 128;
        const int scol = is_lru ? 8 * c : C_XBC + 8 * (c - 128);
        const int wcol = is_lru ? 8 * c : 8 * (c - 128);
        const float* cw = is_lru ? p.lru_conv_w : p.ssd_conv_w; const int cwld = is_lru ? 1024 : XBCW;
        const float* cb = is_lru ? p.lru_conv_b : p.ssd_conv_b;
        float w[4][8], bias[8];
#pragma unroll
        for (int j = 0; j < 4; ++j) { const f32x4 a = *(const f32x4*)(cw + j * cwld + wcol), bq = *(const f32x4*)(cw + j * cwld + wcol + 4);
            w[j][0] = a[0]; w[j][1] = a[1]; w[j][2] = a[2]; w[j][3] = a[3]; w[j][4] = bq[0]; w[j][5] = bq[1]; w[j][6] = bq[2]; w[j][7] = bq[3]; }
        { const f32x4 a = *(const f32x4*)(cb + wcol), bq = *(const f32x4*)(cb + wcol + 4);
            bias[0] = a[0]; bias[1] = a[1]; bias[2] = a[2]; bias[3] = a[3]; bias[4] = bq[0]; bias[5] = bq[1]; bias[6] = bq[2]; bias[7] = bq[3]; }
        float h0[8], h1[8], h2[8];
        const int t0 = tb * 16;
#define LOADROW(dst, tt) do { if ((tt) >= 0) { const u32x4 q = *(const u32x4*)(proj + (size_t)rowof(b, (tt)) * LD0 + scol); \
            dst[0] = bflo(q.x); dst[1] = bfhi(q.x); dst[2] = bflo(q.y); dst[3] = bfhi(q.y); dst[4] = bflo(q.z); dst[5] = bfhi(q.z); dst[6] = bflo(q.w); dst[7] = bfhi(q.w); } \
            else { _Pragma("unroll") for (int e = 0; e < 8; ++e) dst[e] = 0.f; } } while (0)
        LOADROW(h0, t0 - 3); LOADROW(h1, t0 - 2); LOADROW(h2, t0 - 1);
#pragma unroll 4
        for (int i = 0; i < 16; ++i) {
            const int t = t0 + i; float cur[8]; LOADROW(cur, t);
            float o[8];
#pragma unroll
            for (int e = 0; e < 8; ++e) { float v = bias[e] + w[0][e] * h0[e] + w[1][e] * h1[e] + w[2][e] * h2[e] + w[3][e] * cur[e]; o[e] = is_lru ? v : siluf_(v); h0[e] = h1[e]; h1[e] = h2[e]; h2[e] = cur[e]; }
            u32x4 q; q.x = pk2(o[0], o[1]); q.y = pk2(o[2], o[3]); q.z = pk2(o[4], o[5]); q.w = pk2(o[6], o[7]);
            const size_t row = (size_t)rowof(b, t);
            if (is_lru) *(u32x4*)(lx + row * 1024 + wcol) = q; else *(u32x4*)(xc + row * XBCW + wcol) = q;
        }
#undef LOADROW
    }
}

__device__ __forceinline__ void phase_ssd_naive(const Params& p) {
    unsigned char* ws = p.ws;
    bf16_t* proj = (bf16_t*)(ws + OFF_P0); const bf16_t* xc = (const bf16_t*)p.out; float* gsq = (float*)(ws + OFF_STATS) + MTOT;
    const int lane = threadIdx.x & 63, wave = threadIdx.x >> 6;
    for (int item = blockIdx.x * 8 + wave; item < NB * 16 * 2; item += gridDim.x * 8) {
        const int b = item >> 5, h = (item >> 1) & 15, ph = item & 1, g = h >> 3;
        const int pp = ph * 32 + (lane & 31), nh = lane >> 5;
        const float dtb = p.ssd_dt_bias[h], a = -__expf(p.ssd_a_log[h]), dsk = p.ssd_d[h];
        float st[64];
#pragma unroll
        for (int n = 0; n < 64; ++n) st[n] = 0.f;
        for (int t = 0; t < LL; ++t) {
            const size_t row = (size_t)rowof(b, t);
            const float xv = bf2f(xc[row * XBCW + h * 64 + pp]);
            const float dt = softplusf_(bf2f(proj[row * LD0 + C_DT + h]) + dtb);
            const float dA = __expf(dt * a), dx = dt * xv;
            const u32x4* Bp = (const u32x4*)(xc + row * XBCW + 1024 + g * 128 + nh * 64); const u32x4* Cp = (const u32x4*)(xc + row * XBCW + 1280 + g * 128 + nh * 64);
            float y = 0.f;
#pragma unroll
            for (int q = 0; q < 8; ++q) {
                const u32x4 bw = Bp[q], cw = Cp[q];
                const float bv[8] = {bflo(bw.x), bfhi(bw.x), bflo(bw.y), bfhi(bw.y), bflo(bw.z), bfhi(bw.z), bflo(bw.w), bfhi(bw.w)};
                const float cv[8] = {bflo(cw.x), bfhi(cw.x), bflo(cw.y), bfhi(cw.y), bflo(cw.z), bfhi(cw.z), bflo(cw.w), bfhi(cw.w)};
#pragma unroll
                for (int e = 0; e < 8; ++e) { st[q * 8 + e] = dA * st[q * 8 + e] + dx * bv[e]; y += cv[e] * st[q * 8 + e]; }
            }
            y += __shfl_xor(y, 32);
            y += dsk * xv;
            const float z = bf2f(proj[row * LD0 + C_Z + h * 64 + pp]);
            const float gv = y * siluf_(z);
            if (nh == 0) proj[row * LD0 + C_Z + h * 64 + pp] = f2bf(gv);
            const float ss = wave_sum(nh == 0 ? gv * gv : 0.f);
            if (lane == 0) atomicAdd(gsq + row * 2 + g, ss);
        }
    }
}

__device__ __forceinline__ void phase_scan(const Params& p, unsigned char* lds, const bool store_en) {
    unsigned char* ws = p.ws;
    bf16_t* proj = (bf16_t*)(ws + OFF_P0); const bf16_t* la = (const bf16_t*)(ws + OFF_LA); const bf16_t* bb = (const bf16_t*)(ws + OFF_BB);
    const int lane = threadIdx.x & 63, seg = threadIdx.x >> 6;
    float* segP = (float*)lds; float* segH = segP + 8 * 128;
    for (int item = blockIdx.x; item < NB * 8; item += gridDim.x) {
        const int b = item >> 3, ch = (item & 7) * 128 + 2 * lane;
        const int nsteps = seg == 0 ? 272 : 256;
        float P0 = 0.f, P1 = 0.f, H0 = 0.f, H1 = 0.f;
#define rowat(i) ((size_t)(seg == 0 ? ((i) < 16 ? (MREAL + b * 16 + (i)) : (b * SEQ + (i) - 16)) : (b * SEQ + seg * 256 + (i))))
        for (int i0 = 0; i0 < nsteps; i0 += 8) {
            unsigned lw[8], bw[8];
#pragma unroll
            for (int j = 0; j < 8; ++j) { const size_t r = rowat(i0 + j); lw[j] = *(const unsigned*)(la + r * 1024 + ch); bw[j] = *(const unsigned*)(bb + r * 1024 + ch); }
#pragma unroll
            for (int j = 0; j < 8; ++j) { const float l0 = bflo(lw[j]), l1 = bfhi(lw[j]); P0 += l0; P1 += l1; H0 = __expf(l0) * H0 + bflo(bw[j]); H1 = __expf(l1) * H1 + bfhi(bw[j]); }
        }
        __syncthreads();
        segP[seg * 128 + 2 * lane] = P0; segP[seg * 128 + 2 * lane + 1] = P1; segH[seg * 128 + 2 * lane] = H0; segH[seg * 128 + 2 * lane + 1] = H1;
        __syncthreads();
        float h0 = 0.f, h1 = 0.f;
        for (int s = 0; s < seg; ++s) { h0 = __expf(segP[s * 128 + 2 * lane]) * h0 + segH[s * 128 + 2 * lane]; h1 = __expf(segP[s * 128 + 2 * lane + 1]) * h1 + segH[s * 128 + 2 * lane + 1]; }
        for (int i0 = 0; i0 < nsteps; i0 += 8) {
            unsigned lw[8], bw[8], gw[8];
#pragma unroll
            for (int j = 0; j < 8; ++j) { const size_t r = rowat(i0 + j); lw[j] = *(const unsigned*)(la + r * 1024 + ch); bw[j] = *(const unsigned*)(bb + r * 1024 + ch); gw[j] = *(const unsigned*)(proj + r * LD0 + C_LRUG + ch); }
#pragma unroll
            for (int j = 0; j < 8; ++j) {
                h0 = __expf(bflo(lw[j])) * h0 + bflo(bw[j]); h1 = __expf(bfhi(lw[j])) * h1 + bfhi(bw[j]);
                const size_t r = rowat(i0 + j);
                if (store_en) *(unsigned*)(proj + r * LD0 + C_LRUG + ch) = pk2(h0 * siluf_(bflo(gw[j])), h1 * siluf_(bfhi(gw[j])));
            }
        }
    }
#undef rowat
    const float* gsq = (const float*)(ws + OFF_STATS) + MTOT;
    const long total = (long)MTOT * 128;
    for (long it = (long)blockIdx.x * NTHREADS + threadIdx.x; it < total; it += (long)gridDim.x * NTHREADS) {
        const int c = (int)(it & 127); const size_t row = (size_t)(it >> 7);
        const float s = rsqrtf(gsq[row * 2 + (c >> 6)] * (1.f / 512.f) + EPS);
        u32x4* ptr = (u32x4*)(proj + row * LD0 + C_Z + 8 * c);
        const u32x4 q = *ptr; u32x4 o;
        o.x = pk2(bflo(q.x) * s, bfhi(q.x) * s); o.y = pk2(bflo(q.y) * s, bfhi(q.y) * s); o.z = pk2(bflo(q.z) * s, bfhi(q.z) * s); o.w = pk2(bflo(q.w) * s, bfhi(q.w) * s);
        if (store_en) *ptr = o;
    }
}

__device__ __forceinline__ void phase_attn_naive(const Params& p) {
    unsigned char* ws = p.ws;
    const bf16_t* qkvg = (const bf16_t*)(ws + OFF_P0); bf16_t* og = (bf16_t*)(ws + OFF_LA);
    const int lane = threadIdx.x & 63, wave = threadIdx.x >> 6;
    for (int item = blockIdx.x * 8 + wave; item < NB * 16 * 32; item += gridDim.x * 8) {
        const int qb = 31 - (item >> 9), bh = item & 511, b = bh >> 4, h = bh & 15;
        const int u = qb * 64 + lane, t = u + NMETA; const size_t row = (size_t)b * SEQ + u;
        float q[64], o[64];
        { const u32x4* qp = (const u32x4*)(qkvg + row * LD1 + h * 64);
#pragma unroll
          for (int i = 0; i < 8; ++i) { const u32x4 w = qp[i]; q[8 * i] = bflo(w.x); q[8 * i + 1] = bfhi(w.x); q[8 * i + 2] = bflo(w.y); q[8 * i + 3] = bfhi(w.y); q[8 * i + 4] = bflo(w.z); q[8 * i + 5] = bfhi(w.z); q[8 * i + 6] = bflo(w.w); q[8 * i + 7] = bfhi(w.w); } }
#pragma unroll
        for (int d = 0; d < 64; ++d) o[d] = 0.f;
        float R = 0.f;
        const int tmax = qb * 64 + 63 + NMETA;
        for (int s = tmax - 1; s >= 0; --s) {
            const size_t krow = (size_t)rowof(b, s);
            const u32x4* kp = (const u32x4*)(qkvg + krow * LD1 + 1024 + h * 64); const u32x4* vp = (const u32x4*)(qkvg + krow * LD1 + 2048 + h * 64);
            float z = 0.f;
#pragma unroll
            for (int i = 0; i < 8; ++i) { const u32x4 w = kp[i]; z += q[8 * i] * bflo(w.x) + q[8 * i + 1] * bfhi(w.x) + q[8 * i + 2] * bflo(w.y) + q[8 * i + 3] * bfhi(w.y) + q[8 * i + 4] * bflo(w.z) + q[8 * i + 5] * bfhi(w.z) + q[8 * i + 6] * bflo(w.w) + q[8 * i + 7] * bfhi(w.w); }
            z *= 0.125f;
            const bool valid = s < t;
            const float sp = valid ? softplusf_(z) : 0.f;
            R += sp;
            const float wgt = valid ? __expf(z - R) : 0.f;
#pragma unroll
            for (int i = 0; i < 8; ++i) { const u32x4 w = vp[i]; o[8 * i] += wgt * bflo(w.x); o[8 * i + 1] += wgt * bfhi(w.x); o[8 * i + 2] += wgt * bflo(w.y); o[8 * i + 3] += wgt * bfhi(w.y); o[8 * i + 4] += wgt * bflo(w.z); o[8 * i + 5] += wgt * bfhi(w.z); o[8 * i + 6] += wgt * bflo(w.w); o[8 * i + 7] += wgt * bfhi(w.w); }
        }
        const u32x4* gp = (const u32x4*)(qkvg + row * LD1 + 3072 + h * 64); u32x4* op = (u32x4*)(og + row * 1024 + h * 64);
#pragma unroll
        for (int i = 0; i < 8; ++i) { const u32x4 w = gp[i]; u32x4 r;
            r.x = pk2(o[8 * i] * siluf_(bflo(w.x)), o[8 * i + 1] * siluf_(bfhi(w.x))); r.y = pk2(o[8 * i + 2] * siluf_(bflo(w.y)), o[8 * i + 3] * siluf_(bfhi(w.y)));
            r.z = pk2(o[8 * i + 4] * siluf_(bflo(w.z)), o[8 * i + 5] * siluf_(bfhi(w.z))); r.w = pk2(o[8 * i + 6] * siluf_(bflo(w.w)), o[8 * i + 7] * siluf_(bfhi(w.w)));
            op[i] = r; }
    }
}


typedef float f32x16 __attribute__((ext_vector_type(16)));
typedef short v4i16_t __attribute__((ext_vector_type(4)));
__device__ __forceinline__ f32x4 mfma16(bf16x8 a, bf16x8 b, f32x4 c) { return __builtin_amdgcn_mfma_f32_16x16x32_bf16(a, b, c, 0, 0, 0); }
__device__ __forceinline__ f32x16 mfma32(bf16x8 a, bf16x8 b, f32x16 c) { return __builtin_amdgcn_mfma_f32_32x32x16_bf16(a, b, c, 0, 0, 0); }
__device__ __forceinline__ v4i16_t trd(const LAS unsigned char* p) { return __builtin_amdgcn_ds_read_tr16_b64_v4i16((LAS v4i16_t*)p); }
__device__ __forceinline__ bf16x8 tr8(const LAS unsigned char* p0, const LAS unsigned char* p1) { const v4i16_t lo = trd(p0), hi = trd(p1); return (bf16x8){lo[0], lo[1], lo[2], lo[3], hi[0], hi[1], hi[2], hi[3]}; }
__device__ __forceinline__ bf16x8 ldsb8(const LAS unsigned char* p) { return *(const LAS bf16x8*)p; }

__device__ __forceinline__ void phase_ssd(const Params& p, unsigned char* lds_raw, const bool store_en) {
    constexpr int SC = 272, SX = 144;
    constexpr int O_CT = 0, O_BM = 17408, O_SB = 34816, O_X = 52224, O_XW = 61440, O_G = 70656, O_AC = 79872, O_DT = 80128;
    LAS unsigned char* lds = (LAS unsigned char*)lds_raw;
    unsigned char* ws = p.ws;
    bf16_t* proj = (bf16_t*)(ws + OFF_P0); const bf16_t* xc = (const bf16_t*)p.out; float* gsq = (float*)(ws + OFF_STATS) + MTOT;
    const int tid = threadIdx.x, lane = tid & 63, w = __builtin_amdgcn_readfirstlane(tid >> 6), fr = lane & 15, fq = lane >> 4;
    const int lx_ = tid >> 3, cx = tid & 7;
    LAS float* acum_s = (LAS float*)(lds + O_AC); LAS float* dt_s = (LAS float*)(lds + O_DT);
    for (int item = blockIdx.x; item < NB * 16; item += gridDim.x) {
        const int b = item >> 4, h = item & 15, g = h >> 3;
        const float dtb = p.ssd_dt_bias[h], a = -__expf(p.ssd_a_log[h]), dsk = p.ssd_d[h];
        for (int i = tid; i < 17408 / 16; i += NTHREADS) *(LAS u32x4*)(lds + O_SB + 16 * i) = (u32x4){0u, 0u, 0u, 0u};
        f32x4 st[4];
#pragma unroll
        for (int q = 0; q < 4; ++q) st[q] = (f32x4){0.f, 0.f, 0.f, 0.f};
        u32x4 xreg, breg[2], creg[2]; unsigned short dtreg;
#define SSD_ROW(cc, l) ((size_t)((cc) > 0 ? b * SEQ + 64 * ((cc) - 1) + (l) : MREAL + 16 * b + ((l) < 15 ? (l) : 15)))
#define SSD_VALID(cc, l) ((cc) > 0 || (l) < 16)
#define SSD_LOAD(cc) do { \
            xreg = *(const u32x4*)(xc + SSD_ROW(cc, lx_) * XBCW + 64 * h + 8 * cx); \
            _Pragma("unroll") for (int i_ = 0; i_ < 2; ++i_) { const int idx = tid + 512 * i_; const size_t rb = SSD_ROW(cc, idx >> 4); \
                breg[i_] = *(const u32x4*)(xc + rb * XBCW + 1024 + 128 * g + 8 * (idx & 15)); creg[i_] = *(const u32x4*)(xc + rb * XBCW + 1280 + 128 * g + 8 * (idx & 15)); } \
            dtreg = proj[SSD_ROW(cc, lane) * LD0 + C_DT + h]; } while (0)
#define SSD_WRITE(cc) do { \
            float dt_ = SSD_VALID(cc, lane) ? softplusf_(bf2f(dtreg) + dtb) : 0.f; \
            float ac_ = dt_ * a; \
            _Pragma("unroll") for (int o_ = 1; o_ < 64; o_ <<= 1) { const float v_ = __shfl_up(ac_, o_); if (lane >= o_) ac_ += v_; } \
            const float atot_ = __shfl(ac_, 63); const float dtw_ = dt_ * __expf(atot_ - ac_); \
            if (w == 0) { acum_s[lane] = ac_; dt_s[lane] = dt_; } \
            const float mydtw = __shfl(dtw_, lx_ & 63); const bool vx = SSD_VALID(cc, lx_); \
            { u32x4 q_ = xreg; if (!vx) q_ = (u32x4){0u, 0u, 0u, 0u}; *(LAS u32x4*)(lds + O_X + lx_ * SX + 16 * cx) = q_; \
              u32x4 o_; o_.x = pk2(bflo(q_.x) * mydtw, bfhi(q_.x) * mydtw); o_.y = pk2(bflo(q_.y) * mydtw, bfhi(q_.y) * mydtw); o_.z = pk2(bflo(q_.z) * mydtw, bfhi(q_.z) * mydtw); o_.w = pk2(bflo(q_.w) * mydtw, bfhi(q_.w) * mydtw); \
              *(LAS u32x4*)(lds + O_XW + lx_ * SX + 16 * cx) = o_; } \
            _Pragma("unroll") for (int i_ = 0; i_ < 2; ++i_) { const int idx = tid + 512 * i_; const int l_ = idx >> 4; const bool v_ = SSD_VALID(cc, l_); \
                *(LAS u32x4*)(lds + O_BM + l_ * SC + 16 * (idx & 15)) = v_ ? breg[i_] : (u32x4){0u, 0u, 0u, 0u}; \
                *(LAS u32x4*)(lds + O_CT + l_ * SC + 16 * (idx & 15)) = v_ ? creg[i_] : (u32x4){0u, 0u, 0u, 0u}; } } while (0)
        SSD_LOAD(0); SSD_WRITE(0);
        __syncthreads();
        for (int c = 0; c < 33; ++c) {
            const int tl2 = w & 3, l2 = 16 * tl2 + fr; const size_t row2 = SSD_ROW(c, l2); const bool v2 = SSD_VALID(c, l2);
            u32x2 zreg[2];
#pragma unroll
            for (int e = 0; e < 2; ++e) zreg[e] = *(const u32x2*)(proj + row2 * LD0 + C_Z + 64 * h + 16 * (2 * (w >> 2) + e) + 4 * fq);
            __builtin_amdgcn_sched_barrier(0);
            { const int cn = c + 1 < 33 ? c + 1 : 32; SSD_LOAD(cn); }
            __builtin_amdgcn_sched_barrier(0);
            {
                const int tl = w >> 1, l = 16 * tl + fr; const float al = acum_s[l];
#pragma unroll
                for (int e = 0; e < 2; ++e) {
                    const int ts = 2 * (w & 1) + e, s0 = 16 * ts + 4 * fq;
                    u32x2 gw = (u32x2){0u, 0u};
                    if (ts <= tl) {
                        f32x4 acc = (f32x4){0.f, 0.f, 0.f, 0.f};
#pragma unroll
                        for (int ks = 0; ks < 4; ++ks) acc = mfma16(ldsb8(lds + O_BM + (16 * ts + fr) * SC + 64 * ks + 16 * fq), ldsb8(lds + O_CT + l * SC + 64 * ks + 16 * fq), acc);
                        const f32x4 as4 = *(const LAS f32x4*)(acum_s + s0), dt4 = *(const LAS f32x4*)(dt_s + s0);
                        float gv[4];
#pragma unroll
                        for (int j = 0; j < 4; ++j) gv[j] = (s0 + j <= l) ? acc[j] * __expf(al - as4[j]) * dt4[j] : 0.f;
                        gw.x = pk2(gv[0], gv[1]); gw.y = pk2(gv[2], gv[3]);
                    }
                    *(LAS u32x2*)(lds + O_G + l * SX + 2 * s0) = gw;
                }
            }
            {
                const float ea = __expf(acum_s[63]); const int tp = w & 3;
#pragma unroll
                for (int q = 0; q < 4; ++q) {
                    const int tn = 4 * (w >> 2) + q;
                    st[q] = st[q] * ea;
#pragma unroll
                    for (int ks = 0; ks < 2; ++ks) {
                        const int r0 = 32 * ks + 8 * fq + (fr >> 2);
                        const bf16x8 af = tr8(lds + O_BM + r0 * SC + 2 * (16 * tn + 4 * (fr & 3)), lds + O_BM + (r0 + 4) * SC + 2 * (16 * tn + 4 * (fr & 3)));
                        const bf16x8 bf = tr8(lds + O_XW + r0 * SX + 2 * (16 * tp + 4 * (fr & 3)), lds + O_XW + (r0 + 4) * SX + 2 * (16 * tp + 4 * (fr & 3)));
                        st[q] = mfma16(af, bf, st[q]);
                    }
                }
            }
            __syncthreads();
            {
                const float eal = __expf(acum_s[l2]); float ss = 0.f;
#pragma unroll
                for (int e = 0; e < 2; ++e) {
                    const int tp = 2 * (w >> 2) + e;
                    f32x4 y1 = (f32x4){0.f, 0.f, 0.f, 0.f}, y2 = (f32x4){0.f, 0.f, 0.f, 0.f};
#pragma unroll
                    for (int ks = 0; ks < 2; ++ks) {
                        const int r0 = 32 * ks + 8 * fq + (fr >> 2);
                        const bf16x8 af = tr8(lds + O_X + r0 * SX + 2 * (16 * tp + 4 * (fr & 3)), lds + O_X + (r0 + 4) * SX + 2 * (16 * tp + 4 * (fr & 3)));
                        y1 = mfma16(af, ldsb8(lds + O_G + l2 * SX + 64 * ks + 16 * fq), y1);
                    }
#pragma unroll
                    for (int ks = 0; ks < 4; ++ks) y2 = mfma16(ldsb8(lds + O_SB + (16 * tp + fr) * SC + 64 * ks + 16 * fq), ldsb8(lds + O_CT + l2 * SC + 64 * ks + 16 * fq), y2);
                    const int p0 = 16 * tp + 4 * fq;
                    const u32x2 xw_ = *(const LAS u32x2*)(lds + O_X + l2 * SX + 2 * p0);
                    const float xv[4] = {bflo(xw_.x), bfhi(xw_.x), bflo(xw_.y), bfhi(xw_.y)};
                    const float zv[4] = {bflo(zreg[e].x), bfhi(zreg[e].x), bflo(zreg[e].y), bfhi(zreg[e].y)};
                    float gv[4];
#pragma unroll
                    for (int j = 0; j < 4; ++j) { gv[j] = (y1[j] + eal * y2[j] + dsk * xv[j]) * siluf_(zv[j]); ss += gv[j] * gv[j]; }
                    if (v2 && store_en) { u32x2 o_; o_.x = pk2(gv[0], gv[1]); o_.y = pk2(gv[2], gv[3]); *(u32x2*)(proj + row2 * LD0 + C_Z + 64 * h + p0) = o_; }
                }
                ss += __shfl_xor(ss, 16); ss += __shfl_xor(ss, 32);
                if (fq == 0 && v2 && store_en) atomicAdd(gsq + row2 * 2 + g, ss);
            }
            __syncthreads();
            {
                const int tp = w & 3;
#pragma unroll
                for (int q = 0; q < 4; ++q) { const int tn = 4 * (w >> 2) + q; u32x2 o_; o_.x = pk2(st[q][0], st[q][1]); o_.y = pk2(st[q][2], st[q][3]);
                    *(LAS u32x2*)(lds + O_SB + (16 * tp + fr) * SC + 2 * (16 * tn + 4 * fq)) = o_; }
            }
            if (c + 1 < 33) SSD_WRITE(c + 1);
            __syncthreads();
        }
#undef SSD_ROW
#undef SSD_VALID
#undef SSD_LOAD
#undef SSD_WRITE
    }
}

template <bool MASKED>
__device__ __forceinline__ void sb_block(const f32x16& pz, int kb, int hh, int lim, float& carry, unsigned* pw) {
    constexpr float SCL = 0.125f * 1.4426950408889634f;
    float zl[16], sp[16];
#pragma unroll
    for (int r = 0; r < 16; ++r) {
        zl[r] = pz[r] * SCL;
        const float e = __builtin_amdgcn_exp2f(-fabsf(zl[r]));
        float s_ = fmaxf(zl[r], 0.f) + __builtin_amdgcn_logf(1.f + e);
        if (MASKED) { const int kk = 32 * kb + (r & 3) + 8 * (r >> 2) + 4 * hh; s_ = kk < lim ? s_ : 0.f; }
        sp[r] = s_;
    }
    float gs[4], pg[4];
#pragma unroll
    for (int g = 0; g < 4; ++g) { gs[g] = (sp[4 * g] + sp[4 * g + 1]) + (sp[4 * g + 2] + sp[4 * g + 3]); pg[g] = __shfl_xor(gs[g], 32); }
    float acc = carry, R[16];
#pragma unroll
    for (int g = 3; g >= 0; --g) {
        const float base = acc + (hh == 0 ? pg[g] : 0.f);
        acc += gs[g] + pg[g];
        R[4 * g + 3] = base + sp[4 * g + 3]; R[4 * g + 2] = R[4 * g + 3] + sp[4 * g + 2]; R[4 * g + 1] = R[4 * g + 2] + sp[4 * g + 1]; R[4 * g] = R[4 * g + 1] + sp[4 * g];
    }
    carry = acc;
    float wv[16];
#pragma unroll
    for (int r = 0; r < 16; ++r) {
        wv[r] = __builtin_amdgcn_exp2f(zl[r] - R[r]);
        if (MASKED) { const int kk = 32 * kb + (r & 3) + 8 * (r >> 2) + 4 * hh; wv[r] = kk < lim ? wv[r] : 0.f; }
    }
#pragma unroll
    for (int i = 0; i < 8; ++i) pw[i] = pk2(wv[2 * i], wv[2 * i + 1]);
}

__device__ __forceinline__ void phase_attn(const Params& p, unsigned char* lds_raw) {
    LAS unsigned char* lds = (LAS unsigned char*)lds_raw;
    unsigned char* ws = p.ws;
    const bf16_t* qkvg = (const bf16_t*)(ws + OFF_P0); bf16_t* og = (bf16_t*)(ws + OFF_LA);
    const int tid = threadIdx.x, lane = tid & 63, wid = __builtin_amdgcn_readfirstlane(tid >> 6), r32 = lane & 31, hh = lane >> 5;
    const int kk = tid >> 3, c8 = tid & 7;
    const unsigned koff = (c8 >> 1) * 2048 + (c8 & 1) * 1024 + kk * 16;
    const unsigned voff = (c8 >> 2) * 4096 + kk * 64 + (c8 & 3) * 16;
    constexpr int O_K = 0, O_V = 16384, O_ST = 32768;
    LAS unsigned* flags = (LAS unsigned*)(lds + O_ST + 8 * 8192);
    for (int it = blockIdx.x; it < NB * 16 * 8; it += gridDim.x) {
        const int j = 7 - (it >> 9), bh = it & 511, b = bh >> 4, h = bh & 15;
        const int NT = 4 * j + 5;
        const int ubase = 256 * j + 32 * wid, u = ubase + r32;
        const size_t qrow = (size_t)b * SEQ + u;
        bf16x8 qr[4];
#pragma unroll
        for (int ks = 0; ks < 4; ++ks) qr[ks] = *(const bf16x8*)(qkvg + qrow * LD1 + h * 64 + 16 * ks + 8 * hh);
#define KEYROW(ti) ((size_t)((ti) > 0 ? b * SEQ + 64 * ((ti) - 1) + kk : MREAL + 16 * b + (kk < 15 ? kk : 15)))
        u32x4 kreg, vreg;
        { const size_t kr = KEYROW(NT - 1); kreg = *(const u32x4*)(qkvg + kr * LD1 + 1024 + h * 64 + 8 * c8); vreg = *(const u32x4*)(qkvg + kr * LD1 + 2048 + h * 64 + 8 * c8); }
        *(LAS u32x4*)(lds + O_K + koff) = kreg; *(LAS u32x4*)(lds + O_V + voff) = vreg;
        __builtin_amdgcn_s_waitcnt(0x0F70);
        __syncthreads();
        f32x16 o0, o1;
#pragma unroll
        for (int r = 0; r < 16; ++r) { o0[r] = 0.f; o1[r] = 0.f; }
        float carry = 0.f; int cur = 0;
        for (int ti = NT - 1; ti >= 0; --ti) {
            if (ti > 0) { const size_t kr = KEYROW(ti - 1); kreg = *(const u32x4*)(qkvg + kr * LD1 + 1024 + h * 64 + 8 * c8); vreg = *(const u32x4*)(qkvg + kr * LD1 + 2048 + h * 64 + 8 * c8); }
            const int kstart = ti > 0 ? 64 * (ti - 1) : 0;
            const bool skip = ti > 0 && (kstart >= ubase + 31);
            if (!skip) {
                const int lim = ti > 0 ? (u - kstart) : 16;
                const bool full = ti > 0 && (ubase - kstart >= 64);
                f32x16 p0, p1;
#pragma unroll
                for (int r = 0; r < 16; ++r) { p0[r] = 0.f; p1[r] = 0.f; }
                const LAS unsigned char* kb_ = lds + O_K + cur * 8192 + hh * 1024 + r32 * 16;
#pragma unroll
                for (int ks = 0; ks < 4; ++ks) { p0 = mfma32(ldsb8(kb_ + ks * 2048), qr[ks], p0); p1 = mfma32(ldsb8(kb_ + ks * 2048 + 512), qr[ks], p1); }
                unsigned pw[16];
                if (full) { sb_block<false>(p1, 1, hh, lim, carry, pw + 8); sb_block<false>(p0, 0, hh, lim, carry, pw); }
                else { sb_block<true>(p1, 1, hh, lim, carry, pw + 8); sb_block<true>(p0, 0, hh, lim, carry, pw); }
                const LAS unsigned char* vb_ = lds + O_V + cur * 8192 + ((lane >> 4) & 1) * 32 + (lane & 3) * 8 + (4 * hh + ((lane & 15) >> 2)) * 64;
#pragma unroll
                for (int ks = 0; ks < 4; ++ks) {
                    const u32x4 pq = (u32x4){pw[4 * ks], pw[4 * ks + 1], pw[4 * ks + 2], pw[4 * ks + 3]};
                    const bf16x8 pa = __builtin_bit_cast(bf16x8, pq);
                    o0 = mfma32(pa, tr8(vb_ + ks * 1024, vb_ + ks * 1024 + 512), o0);
                    o1 = mfma32(pa, tr8(vb_ + 4096 + ks * 1024, vb_ + 4096 + ks * 1024 + 512), o1);
                }
            }
            if (ti > 0) { *(LAS u32x4*)(lds + O_K + (cur ^ 1) * 8192 + koff) = kreg; *(LAS u32x4*)(lds + O_V + (cur ^ 1) * 8192 + voff) = vreg; }
#if SB_EARLY_EXIT
            { const bool wd = !skip && __all(carry > 126.0f); if (lane == 0) flags[(ti & 1) * 8 + wid] = wd ? 1u : 0u; }
#endif
            __syncthreads();
            cur ^= 1;
#if SB_EARLY_EXIT
            { const u32x4 f0 = *(const LAS u32x4*)(flags + (ti & 1) * 8), f1 = *(const LAS u32x4*)(flags + (ti & 1) * 8 + 4);
              const unsigned alldone = f0.x & f0.y & f0.z & f0.w & f1.x & f1.y & f1.z & f1.w;
              if (alldone) break; }
#endif
        }
#undef KEYROW
        LAS float* stg = (LAS float*)(lds + O_ST + wid * 8192);
#pragma unroll
        for (int r = 0; r < 16; ++r) { const int orow = (r & 3) + 8 * (r >> 2) + 4 * hh; stg[orow * 64 + r32] = o0[r]; stg[orow * 64 + 32 + r32] = o1[r]; }
        const size_t qrow0 = (size_t)b * SEQ + ubase;
#pragma unroll
        for (int i = 0; i < 4; ++i) {
            const int row = i * 8 + (lane >> 3), ch = lane & 7;
            const f32x4 a0 = *(const LAS f32x4*)(stg + row * 64 + 8 * ch), a1 = *(const LAS f32x4*)(stg + row * 64 + 8 * ch + 4);
            const u32x4 gq = *(const u32x4*)(qkvg + (qrow0 + row) * LD1 + 3072 + h * 64 + 8 * ch);
            u32x4 o_;
            o_.x = pk2(a0[0] * siluf_(bflo(gq.x)), a0[1] * siluf_(bfhi(gq.x))); o_.y = pk2(a0[2] * siluf_(bflo(gq.y)), a0[3] * siluf_(bfhi(gq.y)));
            o_.z = pk2(a1[0] * siluf_(bflo(gq.z)), a1[1] * siluf_(bfhi(gq.z))); o_.w = pk2(a1[2] * siluf_(bflo(gq.w)), a1[3] * siluf_(bfhi(gq.w)));
            *(u32x4*)(og + (qrow0 + row) * 1024 + h * 64 + 8 * ch) = o_;
        }
    }
}

__device__ __forceinline__ void phase_final(const Params& p) {
    const float* rsq2 = (const float*)(p.ws + OFF_STATS) + 4 * MTOT;
    const long total = (long)MREAL * 256;
    for (long it = (long)blockIdx.x * NTHREADS + threadIdx.x; it < total; it += (long)gridDim.x * NTHREADS) {
        const int c = (int)(it & 255); const size_t row = (size_t)(it >> 8);
        const float s = rsqrtf(rsq2[row] * (1.f / 1024.f) + EPS);
        f32x4* ptr = (f32x4*)(p.out + row * 1024 + 4 * c);
        const f32x4 w = *(const f32x4*)(p.final_norm + 4 * c);
        f32x4 v = *ptr; v = v * s * w; *ptr = v;
    }
}

#define XB_TMO      128
#define XB_XCNT(j)  (256  + 64 * (j))
#define XB_XSUB(j)  (1280 + 64 * (j))
#define XB_XGEN(j)  (2304 + 64 * (j))
#define XB_TOP      3328
#define XB_TOPGEN   3392
#define XCD_BAR_WORDS 3456
#define XB_SPIN_CAP (1u << 20)
__device__ __forceinline__ unsigned xb_ld(unsigned* p)              { return __hip_atomic_load(p, __ATOMIC_RELAXED, __HIP_MEMORY_SCOPE_AGENT); }
__device__ __forceinline__ unsigned xb_add(unsigned* p, unsigned v) { return __hip_atomic_fetch_add(p, v, __ATOMIC_RELAXED, __HIP_MEMORY_SCOPE_AGENT); }
__device__ __forceinline__ unsigned xb_xcc_id() { return (unsigned)__builtin_amdgcn_s_getreg((3 << 11) | 20) & 0xFu; }
#define XB_SPIN(cond, bar) do { unsigned _sp = 0; while (cond) { __builtin_amdgcn_s_sleep(1); \
    if ((++_sp & 255u) == 0u) { if (xb_ld(&(bar)[XB_TMO])) break; if (_sp > XB_SPIN_CAP) { atomicAdd(&(bar)[XB_TMO], 1u); break; } } } } while (0)
struct XcdBarrier { unsigned* bar; unsigned x; volatile LAS unsigned* st; };
__device__ __forceinline__ XcdBarrier xcd_barrier_post(unsigned* bar, volatile LAS unsigned* st) {
    XcdBarrier b; b.bar = bar; b.x = xb_xcc_id(); b.st = st;
    if (threadIdx.x == 0) (void)xb_add(&bar[XB_XCNT(b.x)], 1u);
    return b;
}
__device__ __forceinline__ void xcd_barrier_complete(unsigned* bar, unsigned x, unsigned& nloc, unsigned& nx) {
    const unsigned G = gridDim.x * gridDim.y * gridDim.z;
    unsigned sum, cnt, mine, sp = 0u;
    for (;;) {
        sum = 0u; cnt = 0u; mine = 0u;
#pragma unroll
        for (unsigned j = 0; j < 16; ++j) { const unsigned c = xb_ld(&bar[XB_XCNT(j)]); sum += c; cnt += (c > 0u) ? 1u : 0u; mine = (j == x) ? c : mine; }
        if (sum == G) break;
        __builtin_amdgcn_s_sleep(1);
        if ((++sp & 255u) == 0u) { if (xb_ld(&bar[XB_TMO])) break; if (sp > XB_SPIN_CAP) { atomicAdd(&bar[XB_TMO], 1u); break; } }
    }
    nloc = mine > 0u ? mine : 1u; nx = cnt > 0u ? cnt : 1u;
}
__device__ __forceinline__ void xcd_barrier(const XcdBarrier& b) {
    asm volatile("s_waitcnt vmcnt(0)" ::: "memory");
    __syncthreads();
    if (threadIdx.x == 0) {
        unsigned* bar = b.bar;
        __builtin_amdgcn_s_waitcnt(0);
        unsigned nloc = b.st[0], nx = b.st[1];
        if (nloc == 0u) { xcd_barrier_complete(bar, b.x, nloc, nx); b.st[0] = nloc; b.st[1] = nx; }
        const unsigned old = xb_add(&bar[XB_XSUB(b.x)], 1u);
        const unsigned gen = old / nloc;
        if (old + 1u == (gen + 1u) * nloc) {
            __builtin_amdgcn_fence(__ATOMIC_RELEASE, "agent");
            asm volatile("s_waitcnt vmcnt(0)" ::: "memory");
            const unsigned og = xb_add(&bar[XB_TOP], 1u);
            const unsigned tg = og / nx;
            if (og + 1u == (tg + 1u) * nx) xb_add(&bar[XB_TOPGEN], 1u);
            else XB_SPIN(xb_ld(&bar[XB_TOPGEN]) == tg, bar);
            __builtin_amdgcn_fence(__ATOMIC_ACQUIRE, "agent");
            xb_add(&bar[XB_XGEN(b.x)], 1u);
            asm volatile("s_waitcnt vmcnt(0)" ::: "memory");
        } else {
            XB_SPIN(xb_ld(&bar[XB_XGEN(b.x)]) == gen, bar);
            __builtin_amdgcn_fence(__ATOMIC_ACQUIRE, "agent");
            asm volatile("s_waitcnt vmcnt(0)" ::: "memory");
        }
    }
    __syncthreads();
}

constexpr int LDS_BYTES = 147456;
__global__ void __launch_bounds__(NTHREADS) fwd_kernel(Params p) {
    extern __shared__ __attribute__((aligned(16))) unsigned char lds_raw[];
    LAS unsigned char* lds = (LAS unsigned char*)lds_raw;
    unsigned char* ws = p.ws;
    const int lo = p.ph_lo, hi = p.ph_hi;
    float* stats = (float*)(ws + OFF_STATS);
#ifndef PHMASK
#define PHMASK 0x3ff
#endif
#define IN(k) (((PHMASK >> (k)) & 1) && lo <= (k) && (k) < hi)
#ifndef PROBE_DUP
#define PROBE_DUP -1
#endif
#define REPS(k) _Pragma("clang loop unroll(disable)") for (int rep_ = 0; rep_ < ((PROBE_DUP == (k)) ? 2 : 1); ++rep_)
    volatile LAS unsigned* bst = (volatile LAS unsigned*)(lds + 140000);
    if (threadIdx.x < 4) bst[threadIdx.x] = 0u;
    __syncthreads();
    XcdBarrier xbar = xcd_barrier_post((unsigned*)(ws + OFF_BAR), bst);
#define SEAM(k) do { if (IN(k) && IN((k) + 1)) { if ((k) == 0) cg::this_grid().sync(); else xcd_barrier(xbar); } } while (0)
    if (IN(0)) REPS(0) { phase0(p, lds_raw); }
    SEAM(0);
    if (IN(1)) REPS(1) {
        pg8::Gemm g{(const bf16_t*)(ws + OFF_XB), (const bf16_t*)(ws + OFF_W0T), 1024, 1024, 1024, 0};
        pg8::StaticOrder S; S.init(258, 19, gridDim.x, blockIdx.x);
        pg8::EpiScaleBf16 E{(bf16_t*)(ws + OFF_P0), LD0, stats, EVEN_IN};
        pg8::gemm_phase(lds, g, S, E);
    }
    SEAM(1);
    if (IN(2)) REPS(2) { phase_conv(p); }
    SEAM(2);
    if (IN(3)) {
        REPS(3) {
        pg8::Gemm g{(const bf16_t*)(ws + OFF_XB), (const bf16_t*)(ws + OFF_WGT), 1024, 256, 256, 256};
        pg8::StaticOrder S; S.init(258, 8, gridDim.x, blockIdx.x);
        pg8::EpiGates E{(const bf16_t*)(ws + OFF_XB), p.lru_b_a, p.lru_b_x, stats + 5 * MTOT, (bf16_t*)(ws + OFF_LA), (bf16_t*)(ws + OFF_BB)};
        pg8::gemm_phase(lds, g, S, E);
        }
#if SSD_NAIVE
        phase_ssd_naive(p);
#else
        REPS(33) { phase_ssd(p, lds_raw, !(PROBE_DUP == 33 && rep_ == 0 && p.ph_hi < 100)); }
#endif
    }
    SEAM(3);
    if (IN(4)) REPS(4) { phase_scan(p, lds_raw, !(PROBE_DUP == 4 && rep_ == 0 && p.ph_hi < 100)); }
    SEAM(4);
    if (IN(5)) {
        pg8::Gemm g{(const bf16_t*)(ws + OFF_P0) + C_LRUG, (const bf16_t*)(ws + OFF_WO0T), LD0, 2048, 2048, 0};
        pg8::StaticOrder S; S.init(258, 4, gridDim.x, blockIdx.x);
        pg8::EpiOut0 E{p.x, p.meta, (bf16_t*)(ws + OFF_XB), stats + 3 * MTOT};
        pg8::gemm_phase(lds, g, S, E);
    }
    SEAM(5);
    if (IN(6)) REPS(6) {
        pg8::Gemm g{(const bf16_t*)(ws + OFF_XB), (const bf16_t*)(ws + OFF_W1T), 1024, 1024, 1024, 0};
        pg8::StaticOrder S; S.init(258, 16, gridDim.x, blockIdx.x);
        pg8::EpiScaleBf16 E{(bf16_t*)(ws + OFF_P0), LD1, stats + 3 * MTOT, LD1};
        pg8::gemm_phase(lds, g, S, E);
    }
    SEAM(6);
#if ATTN_NAIVE
    if (IN(7)) { phase_attn_naive(p); }
#else
    if (IN(7)) REPS(7) { phase_attn(p, lds_raw); }
#endif
    SEAM(7);
#if PROBE_DUP == 77
    if (IN(8)) { phase_attn(p, lds_raw); __syncthreads(); }
#endif
    if (IN(8)) {
        pg8::Gemm g{(const bf16_t*)(ws + OFF_LA), (const bf16_t*)(ws + OFF_WO1T), 1024, 1024, 1024, 0};
        pg8::StaticOrder S; S.init(256, 4, gridDim.x, blockIdx.x);
        pg8::EpiOut1 E{(const bf16_t*)(ws + OFF_XB), p.out, stats + 4 * MTOT};
        pg8::gemm_phase(lds, g, S, E);
    }
    SEAM(8);
    if (IN(9)) { phase_final(p); }
#undef IN
#undef SEAM
}

extern "C" void kernel_launch(void* const* d_in, const int* in_sizes, int n_in, void* d_out, int out_size, void* d_ws, size_t ws_size, hipStream_t stream) {
    static int grid = 0;
    if (grid == 0) {
        if (n_in != 22 || ws_size < WS_END) { fprintf(stderr, "kernel_launch: unexpected inputs (n_in %d, ws %zu < %zu)\n", n_in, ws_size, (size_t)WS_END); grid = -1; return; }
        int dev = 0, cus = 0, per_cu = 0;
        hipGetDevice(&dev); hipDeviceGetAttribute(&cus, hipDeviceAttributeMultiprocessorCount, dev);
        hipFuncSetAttribute((const void*)fwd_kernel, hipFuncAttributeMaxDynamicSharedMemorySize, LDS_BYTES);
        hipOccupancyMaxActiveBlocksPerMultiprocessor(&per_cu, (const void*)fwd_kernel, NTHREADS, LDS_BYTES);
        (void)hipGetLastError();
        if (per_cu < 1) per_cu = 1;
        grid = cus * 1;
    }
    if (grid < 0) return;
    Params p{};
    const float** pp = (const float**)&p;
    for (int i = 0; i < 22; ++i) pp[i] = (const float*)d_in[i];
    p.out = (float*)d_out; p.ws = (unsigned char*)d_ws;
    hipMemsetAsync((unsigned char*)d_ws + OFF_BAR, 0, 16384, stream);
#if N_LAUNCH_MODE == 1
    p.ph_lo = 0; p.ph_hi = 10;
    void* args[] = {&p};
    hipError_t e = hipLaunchCooperativeKernel((const void*)fwd_kernel, dim3(grid), dim3(NTHREADS), args, LDS_BYTES, stream);
    if (e != hipSuccess) fprintf(stderr, "cooperative launch failed: %s (grid %d)\n", hipGetErrorString(e), grid);
#else
    for (int ph = 0; ph < 10; ++ph) {
        p.ph_lo = ph; p.ph_hi = ph + 1;
        hipLaunchKernelGGL(fwd_kernel, dim3(grid), dim3(NTHREADS), LDS_BYTES, stream, p);
    }
#endif
}
```
